# Optimizing an MI355X kernel written in HIP

```python
import math
import jax
import jax.numpy as jnp
from jax import lax
import numpy as np

D_MODEL = 1024
BATCH = 16
SEQ = 256
DEPTH = 1
DEC_BATCH = 2
DEC_SEQ = 1024
PAST_LEN = 512

GRID_W = 64
GLA_HEADS = 4
GLA_DK = 64
GLA_DV = 128
GLA_QK = GLA_HEADS * GLA_DK
GLA_WIDTH = GLA_HEADS * GLA_DV
GLA_GATE_RANK = 16
GLA_GATE_TEMP = 16.0
GLA_CHUNK = 64
DIFF_HEADS = 4
DIFF_DH = 64
DIFF_DV = 2 * DIFF_DH
DIFF_QK = DIFF_HEADS * 2 * DIFF_DH
DIFF_WIDTH = DIFF_HEADS * DIFF_DV
MIX_WIDTH = GLA_WIDTH + DIFF_WIDTH
ROPE_PAIRS = DIFF_DH // 4
ROPE_BASE = 10000.0
Q_BLOCK = 128
EPS = 1e-6
PROJ_SIZES = (GLA_QK, GLA_QK, GLA_WIDTH, GLA_GATE_RANK, GLA_GATE_RANK, DIFF_QK, DIFF_QK, DIFF_WIDTH, MIX_WIDTH)
PROJ_WIDTH = 3616

kernel_name = 'hybrid_gla_diffattn_prefix_dit_step'


def rmsnorm(x, gain):
    x32 = x.astype(jnp.float32)
    y = x32 * lax.rsqrt(jnp.mean(x32 * x32, axis=-1, keepdims=True) + EPS)
    return (y * gain.astype(jnp.float32)).astype(x.dtype)


def adaln_params(cvec, w_mod_l, b_mod_l):
    m = jnp.einsum('...d,de->...e', jax.nn.silu(cvec), w_mod_l) + b_mod_l
    shift, scale, gate = jnp.split(m, 3, axis=-1)
    return shift, scale, gate


def axial_rope_tables(rows, dtype):
    row = jnp.repeat(jnp.arange(rows), GRID_W).astype(jnp.float32)
    col = jnp.tile(jnp.arange(GRID_W), rows).astype(jnp.float32)
    inv_freq = ROPE_BASE ** (-jnp.arange(ROPE_PAIRS, dtype=jnp.float32) / ROPE_PAIRS)
    ang_r = row[:, None] * inv_freq[None, :]
    ang_c = col[:, None] * inv_freq[None, :]
    return (jnp.cos(ang_r).astype(dtype), jnp.sin(ang_r).astype(dtype),
            jnp.cos(ang_c).astype(dtype), jnp.sin(ang_c).astype(dtype))


def rotate_pairs(v, cos, sin):
    v1, v2 = jnp.split(v, 2, axis=-1)
    cos = cos[None, :, None, None, :]
    sin = sin[None, :, None, None, :]
    return jnp.concatenate([v1 * cos - v2 * sin, v1 * sin + v2 * cos], axis=-1)


def apply_axial_rope(x, tables):
    cos_r, sin_r, cos_c, sin_c = tables
    xr, xc = jnp.split(x, 2, axis=-1)
    return jnp.concatenate([rotate_pairs(xr, cos_r, sin_r), rotate_pairs(xc, cos_c, sin_c)], axis=-1)


def project(h, w_in_l, w_alpha_l, b_alpha_l):
    bsz, n, _ = h.shape
    p = jnp.einsum('bld,dp->blp', h, w_in_l)
    idx = [int(i) for i in np.cumsum(PROJ_SIZES)[:-1]]
    gq, gk, gv, lr_f, lr_b, dq, dk, dv, gate = jnp.split(p, idx, axis=-1)
    gq = gq.reshape(bsz, n, GLA_HEADS, GLA_DK) * (GLA_DK ** -0.5)
    gk = gk.reshape(bsz, n, GLA_HEADS, GLA_DK)
    gv = gv.reshape(bsz, n, GLA_HEADS, GLA_DV)
    z_f = jnp.einsum('blr,rk->blk', lr_f, w_alpha_l[0]) + b_alpha_l[0]
    z_b = jnp.einsum('blr,rk->blk', lr_b, w_alpha_l[1]) + b_alpha_l[1]
    g_f = (jax.nn.log_sigmoid(z_f.astype(jnp.float32)) / GLA_GATE_TEMP).reshape(bsz, n, GLA_HEADS, GLA_DK)
    g_b = (jax.nn.log_sigmoid(z_b.astype(jnp.float32)) / GLA_GATE_TEMP).reshape(bsz, n, GLA_HEADS, GLA_DK)
    dq = dq.reshape(bsz, n, DIFF_HEADS, 2, DIFF_DH)
    dk = dk.reshape(bsz, n, DIFF_HEADS, 2, DIFF_DH)
    dv = dv.reshape(bsz, n, DIFF_HEADS, DIFF_DV)
    return gq, gk, gv, g_f, g_b, dq, dk, dv, gate


def gla_chunk_scan(q, k, v, g, s0):
    bsz, n, nh, dkk = q.shape
    dvv = v.shape[-1]
    nc = n // GLA_CHUNK

    def to_chunks(a):
        return a.astype(jnp.float32).reshape(bsz, nc, GLA_CHUNK, nh, a.shape[-1]).swapaxes(0, 1)

    causal = jnp.tril(jnp.ones((GLA_CHUNK, GLA_CHUNK), dtype=bool))[None, :, :, None, None]

    def step(s, inp):
        qc, kc, vc, gc = inp
        b = jnp.cumsum(gc, axis=1)
        o_inter = jnp.einsum('bchk,bhkv->bchv', qc * jnp.exp(b), s)
        diff = b[:, :, None] - b[:, None, :]
        decay = jnp.where(causal, jnp.exp(jnp.minimum(diff, 0.0)), 0.0)
        att = jnp.einsum('bthk,btshk,bshk->bhts', qc, decay, kc)
        o_intra = jnp.einsum('bhts,bshv->bthv', att, vc)
        b_last = b[:, -1]
        s_new = jnp.exp(b_last)[..., None] * s + jnp.einsum(
            'bshk,bshv->bhkv', kc * jnp.exp(b_last[:, None] - b), vc)
        return s_new, o_inter + o_intra

    s_fin, o = lax.scan(step, s0.astype(jnp.float32), (to_chunks(q), to_chunks(k), to_chunks(v), to_chunks(g)))
    o = o.swapaxes(0, 1).reshape(bsz, n, nh, dvv)
    return o, s_fin


def gla_bidirectional(q, k, v, g_f, g_b, s0_f, s0_b):
    o_f, s_f = gla_chunk_scan(q, k, v, g_f, s0_f)
    o_b, s_b = gla_chunk_scan(jnp.flip(q, 1), jnp.flip(k, 1), jnp.flip(v, 1), jnp.flip(g_b, 1), s0_b)
    return o_f + jnp.flip(o_b, 1), s_f, s_b


def diff_lambda_value(lam_params, lam_init):
    lp = lam_params.astype(jnp.float32)
    return jnp.exp(jnp.sum(lp[0] * lp[1])) - jnp.exp(jnp.sum(lp[2] * lp[3])) + lam_init


def diff_attention(q, k, v, lam):
    bsz, nq, nh, _, dh = q.shape
    nb = nq // Q_BLOCK
    qb = jnp.moveaxis(q.reshape(bsz, nb, Q_BLOCK, nh, 2, dh), 1, 0)
    scale = dh ** -0.5

    def block(qi):
        s = jnp.einsum('bqhid,bkhid->bihqk', qi, k).astype(jnp.float32) * scale
        p = jax.nn.softmax(s, axis=-1)
        a = p[:, 0] - lam * p[:, 1]
        return jnp.einsum('bhqk,bkhv->bqhv', a.astype(v.dtype), v)

    o = lax.map(block, qb)
    return jnp.moveaxis(o, 0, 1).reshape(bsz, nq, nh, v.shape[-1])


def merge_heads(o_gla, o_diff, gate, gla_gain, diff_gain, lam_init, w_out_l):
    bsz, n = gate.shape[0], gate.shape[1]
    og = rmsnorm(o_gla.astype(gate.dtype), gla_gain).reshape(bsz, n, GLA_WIDTH)
    od = (rmsnorm(o_diff, diff_gain) * (1.0 - lam_init)).reshape(bsz, n, DIFF_WIDTH)
    o = jnp.concatenate([og, od], axis=-1) * jax.nn.silu(gate)
    return jnp.einsum('blm,md->bld', o, w_out_l)


def setup_inputs(seed: int = 0) -> dict:
    key = jax.random.key(seed)
    ks = jax.random.split(key, 19)

    def nrm(k, shape, s):
        return s * jax.random.normal(k, shape, jnp.float32)

    return {
        'x_prompt': nrm(ks[0], (BATCH, SEQ, D_MODEL), 1.0),
        'x_sample': nrm(ks[1], (DEC_BATCH, DEC_SEQ, D_MODEL), 1.0),
        'cache_diff_k': nrm(ks[2], (DEC_BATCH, DEPTH, PAST_LEN, DIFF_HEADS, 2, DIFF_DH), 1.0),
        'cache_diff_v': nrm(ks[3], (DEC_BATCH, DEPTH, PAST_LEN, DIFF_HEADS, DIFF_DV), 1.0),
        'state_gla_fwd': nrm(ks[4], (DEC_BATCH, DEPTH, GLA_HEADS, GLA_DK, GLA_DV), 1.0),
        'state_gla_bwd': nrm(ks[5], (DEC_BATCH, DEPTH, GLA_HEADS, GLA_DK, GLA_DV), 1.0),
        'c': nrm(ks[6], (DEC_BATCH, D_MODEL), 1.0),
        'c_ctx': nrm(ks[7], (D_MODEL,), 1.0),
        'norm_gain': 1.0 + nrm(ks[8], (DEPTH, D_MODEL), 0.02),
        'w_mod': nrm(ks[9], (DEPTH, D_MODEL, 3 * D_MODEL), D_MODEL ** -0.5),
        'b_mod': nrm(ks[10], (DEPTH, 3 * D_MODEL), 0.02),
        'w_in': nrm(ks[11], (DEPTH, D_MODEL, PROJ_WIDTH), D_MODEL ** -0.5),
        'w_gla_alpha': nrm(ks[12], (DEPTH, 2, GLA_GATE_RANK, GLA_QK), GLA_GATE_RANK ** -0.5),
        'b_gla_alpha': 1.0 + nrm(ks[13], (DEPTH, 2, GLA_QK), 0.5),
        'diff_lambda': nrm(ks[14], (DEPTH, 4, DIFF_DH), 0.1),
        'gla_head_gain': 1.0 + nrm(ks[15], (DEPTH, GLA_DV), 0.02),
        'diff_head_gain': 1.0 + nrm(ks[16], (DEPTH, DIFF_DV), 0.02),
        'w_out': nrm(ks[17], (DEPTH, MIX_WIDTH, D_MODEL), MIX_WIDTH ** -0.5),
        'final_gain': 1.0 + nrm(ks[18], (D_MODEL,), 0.02),
    }


def reference(x_prompt, x_sample, cache_diff_k, cache_diff_v, state_gla_fwd, state_gla_bwd, c, c_ctx,
              norm_gain, w_mod, b_mod, w_in, w_gla_alpha, b_gla_alpha, diff_lambda,
              gla_head_gain, diff_head_gain, w_out, final_gain):
    n_lat = x_sample.shape[1]
    ROWS = n_lat // GRID_W
    rope_tables = axial_rope_tables(ROWS, x_sample.dtype)
    bsz_p = x_prompt.shape[0]
    zero_state = jnp.zeros((bsz_p, GLA_HEADS, GLA_DK, GLA_DV), jnp.float32)

    xp = x_prompt
    xs = x_sample
    new_k, new_v, new_sf, new_sb = [], [], [], []
    for l in range(DEPTH):
        lam_init = 0.8 - 0.6 * math.exp(-0.3 * l)
        lam = diff_lambda_value(diff_lambda[l], lam_init)

        sh, sc, gt = adaln_params(c_ctx, w_mod[l], b_mod[l])
        h = rmsnorm(xp, norm_gain[l]) * (1.0 + sc) + sh
        gq, gk, gv, g_f, g_b, dq, dk, dv, gate = project(h, w_in[l], w_gla_alpha[l], b_gla_alpha[l])
        o_gla, s_f, s_b = gla_bidirectional(gq, gk, gv, g_f, g_b, zero_state, zero_state)
        o_diff = diff_attention(dq, dk, dv, lam)
        xp = xp + gt * merge_heads(o_gla, o_diff, gate, gla_head_gain[l], diff_head_gain[l], lam_init, w_out[l])
        new_k.append(dk)
        new_v.append(dv)
        new_sf.append(s_f.astype(x_prompt.dtype))
        new_sb.append(s_b.astype(x_prompt.dtype))

        sh, sc, gt = adaln_params(c, w_mod[l], b_mod[l])
        h = rmsnorm(xs, norm_gain[l]) * (1.0 + sc[:, None, :]) + sh[:, None, :]
        gq, gk, gv, g_f, g_b, dq, dk, dv, gate = project(h, w_in[l], w_gla_alpha[l], b_gla_alpha[l])
        o_gla, _, _ = gla_bidirectional(gq, gk, gv, g_f, g_b, state_gla_fwd[:, l], state_gla_bwd[:, l])
        dq = apply_axial_rope(dq, rope_tables)
        dk = apply_axial_rope(dk, rope_tables)
        k_all = jnp.concatenate([cache_diff_k[:, l], dk], axis=1)
        v_all = jnp.concatenate([cache_diff_v[:, l], dv], axis=1)
        o_diff = diff_attention(dq, k_all, v_all, lam)
        xs = xs + gt[:, None, :] * merge_heads(o_gla, o_diff, gate, gla_head_gain[l], diff_head_gain[l], lam_init, w_out[l])

    y_prompt = rmsnorm(xp, final_gain)
    y_sample = rmsnorm(xs, final_gain)
    new_diff_k = jnp.stack(new_k, axis=1)
    new_diff_v = jnp.stack(new_v, axis=1)
    new_gla_fwd = jnp.stack(new_sf, axis=1)
    new_gla_bwd = jnp.stack(new_sb, axis=1)
    return (y_prompt, y_sample, new_diff_k, new_diff_v, new_gla_fwd, new_gla_bwd)
```

```cpp
#include <hip/hip_runtime.h>
#include <cstdio>
#include <cstdint>

#ifndef MK_N_LAUNCHES
#define MK_N_LAUNCHES 8
#endif

constexpr int D = 1024, NPR = 4096, NSR = 2048, NT = 6144, PW = 3616;
constexpr int C_GQ = 0, C_GK = 256, C_GV = 512, C_LRF = 1024, C_LRB = 1040, C_DQ = 1056, C_DK = 1568, C_DV = 2080, C_GATE = 2592;
constexpr size_t O_Y = 0, O_NK = 6291456, O_NV = 8388608, O_SF = 10485760, O_SB = 11010048;
constexpr int NTHR = 512;
constexpr int LDS_BYTES = 147456;

constexpr size_t MiB = 1u << 20;
constexpr size_t WS_CTL = 0, CTL_ZERO_BYTES = 64 * 1024;
constexpr size_t WS_MOD = 1 * MiB;
constexpr size_t WS_H = 2 * MiB;
constexpr size_t WS_P = 26 * MiB;
constexpr size_t WS_OGF = 112 * MiB;
constexpr size_t WS_OGB = 124 * MiB;
constexpr size_t WS_OD = 136 * MiB;
constexpr size_t WS_MG = 148 * MiB;
constexpr size_t WS_END = 172 * MiB;

#define LAS __attribute__((address_space(3)))

#define XB_TMO      128
#define XB_XCNT(j)  (256  + 64 * (j))
#define XB_XSUB(j)  (1280 + 64 * (j))
#define XB_XGEN(j)  (2304 + 64 * (j))
#define XB_TOP      3328
#define XB_TOPGEN   3392
#define XCD_BAR_WORDS 3456
#define XB_SPIN_CAP (1u << 18)
__device__ __forceinline__ unsigned xb_ld(unsigned* p)              { return __hip_atomic_load(p, __ATOMIC_RELAXED, __HIP_MEMORY_SCOPE_AGENT); }
__device__ __forceinline__ unsigned xb_add(unsigned* p, unsigned v) { return __hip_atomic_fetch_add(p, v, __ATOMIC_RELAXED, __HIP_MEMORY_SCOPE_AGENT); }
__device__ __forceinline__ unsigned xb_xcc_id() { return (unsigned)__builtin_amdgcn_s_getreg((3 << 11) | 20) & 0xFu; }
#define XB_SPIN(cond, bar) do { unsigned _sp = 0; while (cond) { __builtin_amdgcn_s_sleep(1); \
    if ((++_sp & 255u) == 0u) { if (xb_ld(&(bar)[XB_TMO])) break; if (_sp > XB_SPIN_CAP) { atomicAdd(&(bar)[XB_TMO], 1u); break; } } } } while (0)
struct XcdBarrier { unsigned* bar; unsigned x; volatile LAS unsigned* st; };
__device__ __forceinline__ XcdBarrier xcd_barrier_post(unsigned* bar, volatile LAS unsigned* st) {
    XcdBarrier b; b.bar = bar; b.x = xb_xcc_id(); b.st = st;
    if (threadIdx.x == 0) (void)xb_add(&bar[XB_XCNT(b.x)], 1u);
    return b;
}
__device__ __forceinline__ void xcd_barrier_complete(unsigned* bar, unsigned x, unsigned& nloc, unsigned& nx) {
    const unsigned G = gridDim.x * gridDim.y * gridDim.z;
    unsigned sum, cnt, mine, sp = 0u;
    for (;;) {
        sum = 0u; cnt = 0u; mine = 0u;
#pragma unroll
        for (unsigned j = 0; j < 16; ++j) { const unsigned c = xb_ld(&bar[XB_XCNT(j)]); sum += c; cnt += (c > 0u) ? 1u : 0u; mine = (j == x) ? c : mine; }
        if (sum == G) break;
        __builtin_amdgcn_s_sleep(1);
        if ((++sp & 255u) == 0u) { if (xb_ld(&bar[XB_TMO])) break; if (sp > XB_SPIN_CAP) { atomicAdd(&bar[XB_TMO], 1u); break; } }
    }
    nloc = mine > 0u ? mine : 1u; nx = cnt > 0u ? cnt : 1u;
}
__device__ __forceinline__ void xcd_barrier(const XcdBarrier& b) {
    asm volatile("s_waitcnt vmcnt(0)" ::: "memory");
    __syncthreads();
    if (threadIdx.x == 0) {
        unsigned* bar = b.bar;
        __builtin_amdgcn_s_waitcnt(0);
        unsigned nloc = b.st[0], nx = b.st[1];
        if (nloc == 0u) { xcd_barrier_complete(bar, b.x, nloc, nx); b.st[0] = nloc; b.st[1] = nx; }
        const unsigned old = xb_add(&bar[XB_XSUB(b.x)], 1u);
        const unsigned gen = old / nloc;
        if (old + 1u == (gen + 1u) * nloc) {
            __builtin_amdgcn_fence(__ATOMIC_RELEASE, "agent");
            asm volatile("s_waitcnt vmcnt(0)" ::: "memory");
            const unsigned og = xb_add(&bar[XB_TOP], 1u);
            const unsigned tg = og / nx;
            if (og + 1u == (tg + 1u) * nx) xb_add(&bar[XB_TOPGEN], 1u);
            else XB_SPIN(xb_ld(&bar[XB_TOPGEN]) == tg, bar);
            __builtin_amdgcn_fence(__ATOMIC_ACQUIRE, "agent");
            xb_add(&bar[XB_XGEN(b.x)], 1u);
            asm volatile("s_waitcnt vmcnt(0)" ::: "memory");
        } else {
            XB_SPIN(xb_ld(&bar[XB_XGEN(b.x)]) == gen, bar);
            __builtin_amdgcn_fence(__ATOMIC_ACQUIRE, "agent");
            asm volatile("s_waitcnt vmcnt(0)" ::: "memory");
        }
    }
    __syncthreads();
}

struct Args {
    const float* in[19]; float* out; unsigned char* ws; int ph_lo, ph_hi;
};
struct Frame {
    const float *x_prompt, *x_sample, *cache_k, *cache_v, *st_f, *st_b, *c, *c_ctx, *norm_gain, *w_mod, *b_mod, *w_in, *w_alpha, *b_alpha, *dlam, *gla_gain, *diff_gain, *w_out, *final_gain;
    float* out; unsigned char* ws;
    float *MOD, *H, *P, *OGF, *OGB, *OD, *MG;
    int tid, lane, wave, G, bid;
};
__device__ __forceinline__ float wave_sum(float v) {
#pragma unroll
    for (int o = 32; o > 0; o >>= 1) v += __shfl_xor(v, o);
    return v;
}
__device__ __forceinline__ float wave_max(float v) {
#pragma unroll
    for (int o = 32; o > 0; o >>= 1) v = fmaxf(v, __shfl_xor(v, o));
    return v;
}
__device__ __forceinline__ float silu_f(float x) { return x / (1.0f + expf(-x)); }
__device__ __forceinline__ const float* xrow(const Frame& F, int r) { return r < NPR ? F.x_prompt + (size_t)r * D : F.x_sample + (size_t)(r - NPR) * D; }
__device__ __forceinline__ int variant_of(int r) { return r < NPR ? 0 : 1 + (r - NPR) / 1024; }
__device__ __forceinline__ float lam_value(const Frame& F) {
    float a = 0.f, b = 0.f;
    for (int i = 0; i < 64; ++i) { a += F.dlam[i] * F.dlam[64 + i]; b += F.dlam[128 + i] * F.dlam[192 + i]; }
    return expf(a) - expf(b) + 0.2f;
}

__device__ void ph_mod(const Frame& F) {
    for (int e = F.bid * NTHR + F.tid; e < 3072; e += F.G * NTHR) {
        float a0 = 0.f, a1 = 0.f, a2 = 0.f;
        for (int d = 0; d < D; ++d) {
            const float w = F.w_mod[(size_t)d * 3072 + e];
            a0 += silu_f(F.c_ctx[d]) * w; a1 += silu_f(F.c[d]) * w; a2 += silu_f(F.c[D + d]) * w;
        }
        const float bb = F.b_mod[e];
        F.MOD[e] = a0 + bb; F.MOD[3072 + e] = a1 + bb; F.MOD[6144 + e] = a2 + bb;
    }
}
__device__ void ph_h(const Frame& F) {
    for (int r = F.bid * 8 + F.wave; r < NT; r += F.G * 8) {
        const float* x = xrow(F, r); const float* m = F.MOD + variant_of(r) * 3072;
        float4 v[4]; float ss = 0.f;
#pragma unroll
        for (int i = 0; i < 4; ++i) { v[i] = *(const float4*)(x + i * 256 + F.lane * 4); ss += v[i].x * v[i].x + v[i].y * v[i].y + v[i].z * v[i].z + v[i].w * v[i].w; }
        ss = wave_sum(ss);
        const float rstd = 1.0f / sqrtf(ss * (1.0f / 1024.0f) + 1e-6f);
#pragma unroll
        for (int i = 0; i < 4; ++i) {
            const int k = i * 256 + F.lane * 4;
            const float4 g = *(const float4*)(F.norm_gain + k), sh = *(const float4*)(m + k), sc = *(const float4*)(m + 1024 + k);
            float4 o;
            o.x = v[i].x * rstd * g.x * (1.0f + sc.x) + sh.x; o.y = v[i].y * rstd * g.y * (1.0f + sc.y) + sh.y;
            o.z = v[i].z * rstd * g.z * (1.0f + sc.z) + sh.z; o.w = v[i].w * rstd * g.w * (1.0f + sc.w) + sh.w;
            *(float4*)(F.H + (size_t)r * D + k) = o;
        }
    }
}
template <class Epi>
__device__ void gemm_naive(const Frame& F, LAS float* lds, const float* A, int lda, const float* B, int ldb, int M, int N, int K, const Epi& E) {
    LAS float* As = lds;
    LAS float* Bs = lds + 16 * 132;
    const int ntn = (N + 63) / 64, ntm = M / 128, nt = ntn * ntm;
    const int tid = F.tid, ty = tid >> 4, tx = tid & 15;
    for (int t = F.bid; t < nt; t += F.G) {
        const int tm = t / ntn, tn = t % ntn, row0 = tm * 128, col0 = tn * 64;
        float acc[4][4];
#pragma unroll
        for (int i = 0; i < 4; ++i)
#pragma unroll
            for (int j = 0; j < 4; ++j) acc[i][j] = 0.f;
        for (int k0 = 0; k0 < K; k0 += 16) {
            { const int r = tid >> 2, kq = (tid & 3) * 4; const float4 a = *(const float4*)(A + (size_t)(row0 + r) * lda + k0 + kq);
              As[(kq + 0) * 132 + r] = a.x; As[(kq + 1) * 132 + r] = a.y; As[(kq + 2) * 132 + r] = a.z; As[(kq + 3) * 132 + r] = a.w; }
            { const int k = tid >> 5, c = (tid & 31) * 2; float2 b = make_float2(0.f, 0.f); if (col0 + c < N) b = *(const float2*)(B + (size_t)(k0 + k) * ldb + col0 + c);
              Bs[k * 64 + c] = b.x; Bs[k * 64 + c + 1] = b.y; }
            __syncthreads();
#pragma unroll
            for (int kk = 0; kk < 16; ++kk) {
                float a[4], b[4];
#pragma unroll
                for (int i = 0; i < 4; ++i) { a[i] = As[kk * 132 + ty * 4 + i]; b[i] = Bs[kk * 64 + tx * 4 + i]; }
#pragma unroll
                for (int i = 0; i < 4; ++i)
#pragma unroll
                    for (int j = 0; j < 4; ++j) acc[i][j] += a[i] * b[j];
            }
            __syncthreads();
        }
#pragma unroll
        for (int i = 0; i < 4; ++i)
#pragma unroll
            for (int j = 0; j < 4; ++j) { const int r = row0 + ty * 4 + i, c = col0 + tx * 4 + j; if (c < N) E(r, c, acc[i][j]); }
    }
}
struct EpiIn { float* P; float* out;
    __device__ __forceinline__ void operator()(int r, int c, float v) const {
        P[(size_t)r * PW + c] = v;
        if (r < NPR) { if (c >= C_DK && c < C_DV) out[O_NK + (size_t)r * 512 + (c - C_DK)] = v; else if (c >= C_DV && c < C_GATE) out[O_NV + (size_t)r * 512 + (c - C_DV)] = v; }
    } };
struct EpiOut { const Frame* F;
    __device__ __forceinline__ void operator()(int r, int c, float v) const {
        const float gt = F->MOD[variant_of(r) * 3072 + 2048 + c];
        F->out[(size_t)r * D + c] = xrow(*F, r)[c] + gt * v;
    } };
__device__ void ph_rope(const Frame& F) {
    const long total = (long)NSR * 512;
    for (long idx = (long)F.bid * NTHR + F.tid; idx < total; idx += (long)F.G * NTHR) {
        const int p = (int)(idx & 31), vec = (int)((idx >> 5) & 7), which = (int)((idx >> 8) & 1), rs = (int)(idx >> 9);
        const int t = rs & 1023, gr = t >> 6, gc = t & 63;
        const int i = p & 15; const int pos = p < 16 ? gr : gc; const int d1 = (p < 16 ? 0 : 32) + i, d2 = d1 + 16;
        const float inv = powf(10000.0f, -(float)i / 16.0f);
        const float ang = (float)pos * inv, cs = cosf(ang), sn = sinf(ang);
        float* base = F.P + (size_t)(NPR + rs) * PW + (which ? C_DK : C_DQ) + vec * 64;
        const float v1 = base[d1], v2 = base[d2];
        base[d1] = v1 * cs - v2 * sn; base[d2] = v1 * sn + v2 * cs;
    }
}
__device__ __forceinline__ float log_sigmoid_f(float z) { return fminf(z, 0.f) - log1pf(expf(-fabsf(z))); }
__device__ void ph_gla(const Frame& F, LAS float* lds) {
    LAS float* al = lds;
    LAS float* qs = al + 4096;
    LAS float* ks = qs + 4096;
    LAS float* vs = ks + 4096;
    LAS float* po = vs + 8192;
    const int tid = F.tid, j = tid & 127, kq = tid >> 7;
    for (int item = F.bid; item < 144; item += F.G) {
        int grp, b, h, dir;
        if (item < 128) { grp = 0; b = item >> 3; h = (item >> 1) & 3; dir = item & 1; } else { const int it = item - 128; grp = 1; b = it >> 3; h = (it >> 1) & 3; dir = it & 1; }
        const int R0 = grp == 0 ? b * 256 : NPR + b * 1024, n = grp == 0 ? 256 : 1024;
        float S[16];
        if (grp == 0) {
#pragma unroll
            for (int i = 0; i < 16; ++i) S[i] = 0.f;
        } else {
            const float* st = (dir == 0 ? F.st_f : F.st_b) + (size_t)(b * 4 + h) * 64 * 128;
#pragma unroll
            for (int i = 0; i < 16; ++i) S[i] = st[(kq * 16 + i) * 128 + j];
        }
        float* OG = dir == 0 ? F.OGF : F.OGB;
        for (int c0 = 0; c0 < n; c0 += 64) {
            __syncthreads();
            for (int e = tid; e < 4096; e += NTHR) {
                const int s = e >> 6, k = e & 63; const int t = dir == 0 ? c0 + s : n - 1 - (c0 + s); const float* prow = F.P + (size_t)(R0 + t) * PW;
                float z = F.b_alpha[dir * 256 + h * 64 + k];
                for (int r = 0; r < 16; ++r) z += prow[(dir == 0 ? C_LRF : C_LRB) + r] * F.w_alpha[(size_t)(dir * 16 + r) * 256 + h * 64 + k];
                al[e] = expf(log_sigmoid_f(z) * (1.0f / 16.0f));
                qs[e] = prow[C_GQ + h * 64 + k] * 0.125f;
                ks[e] = prow[C_GK + h * 64 + k];
            }
            for (int e = tid; e < 8192; e += NTHR) {
                const int s = e >> 7, jj = e & 127; const int t = dir == 0 ? c0 + s : n - 1 - (c0 + s);
                vs[e] = F.P[(size_t)(R0 + t) * PW + C_GV + h * 128 + jj];
            }
            __syncthreads();
            for (int s = 0; s < 64; ++s) {
                const float v = vs[s * 128 + j]; float o = 0.f;
#pragma unroll
                for (int i = 0; i < 16; ++i) { const int k = kq * 16 + i; S[i] = al[s * 64 + k] * S[i] + ks[s * 64 + k] * v; o += qs[s * 64 + k] * S[i]; }
                po[((s & 1) * 4 + kq) * 128 + j] = o;
                __syncthreads();
                if (kq == 0) {
                    const int t = dir == 0 ? c0 + s : n - 1 - (c0 + s);
                    const int pb = (s & 1) * 4;
                    OG[(size_t)(R0 + t) * 512 + h * 128 + j] = po[(pb + 0) * 128 + j] + po[(pb + 1) * 128 + j] + po[(pb + 2) * 128 + j] + po[(pb + 3) * 128 + j];
                }
            }
        }
        if (grp == 0) {
            float* so = F.out + (dir == 0 ? O_SF : O_SB) + (size_t)(b * 4 + h) * 64 * 128;
#pragma unroll
            for (int i = 0; i < 16; ++i) so[(kq * 16 + i) * 128 + j] = S[i];
        }
    }
}
__device__ void ph_diff(const Frame& F, LAS float* lds) {
    LAS float* wl = lds + F.wave * 3328;
    LAS float* qb = wl; LAS float* s1 = wl + 128; LAS float* s2 = s1 + 1536;
    const float lam = lam_value(F);
    const int lane = F.lane;
    for (int item = F.bid * 8 + F.wave; item < NT * 4; item += F.G * 8) {
        const int r = item >> 2, h = item & 3;
        int R0, nc, nk, b;
        if (r < NPR) { b = r >> 8; R0 = b * 256; nc = 0; nk = 256; } else { b = (r - NPR) >> 10; R0 = NPR + b * 1024; nc = 512; nk = 1536; }
        const float* qp = F.P + (size_t)r * PW + C_DQ + h * 128;
        qb[lane] = qp[lane]; qb[64 + lane] = qp[64 + lane];
        __builtin_amdgcn_wave_barrier();
        float m1 = -3.0e38f, m2 = -3.0e38f;
        for (int jk = lane; jk < nk; jk += 64) {
            const float* kp = jk < nc ? F.cache_k + ((size_t)(b * 512 + jk) * 4 + h) * 128 : F.P + (size_t)(R0 + jk - nc) * PW + C_DK + h * 128;
            float a1 = 0.f, a2 = 0.f;
            for (int d = 0; d < 64; d += 4) {
                const float4 k1 = *(const float4*)(kp + d), k2 = *(const float4*)(kp + 64 + d);
                a1 += qb[d] * k1.x + qb[d + 1] * k1.y + qb[d + 2] * k1.z + qb[d + 3] * k1.w;
                a2 += qb[64 + d] * k2.x + qb[64 + d + 1] * k2.y + qb[64 + d + 2] * k2.z + qb[64 + d + 3] * k2.w;
            }
            a1 *= 0.125f; a2 *= 0.125f; s1[jk] = a1; s2[jk] = a2; m1 = fmaxf(m1, a1); m2 = fmaxf(m2, a2);
        }
        m1 = wave_max(m1); m2 = wave_max(m2);
        float l1 = 0.f, l2 = 0.f;
        for (int jk = lane; jk < nk; jk += 64) { const float e1 = expf(s1[jk] - m1), e2 = expf(s2[jk] - m2); s1[jk] = e1; s2[jk] = e2; l1 += e1; l2 += e2; }
        l1 = wave_sum(l1); l2 = wave_sum(l2);
        const float i1 = 1.0f / l1, i2 = lam / l2;
        for (int jk = lane; jk < nk; jk += 64) s1[jk] = s1[jk] * i1 - s2[jk] * i2;
        __builtin_amdgcn_wave_barrier();
        float2 acc = make_float2(0.f, 0.f);
        for (int jk = 0; jk < nk; ++jk) {
            const float* vp = jk < nc ? F.cache_v + ((size_t)(b * 512 + jk) * 4 + h) * 128 : F.P + (size_t)(R0 + jk - nc) * PW + C_DV + h * 128;
            const float a = s1[jk]; const float2 v = *(const float2*)(vp + lane * 2);
            acc.x += a * v.x; acc.y += a * v.y;
        }
        *(float2*)(F.OD + (size_t)r * 512 + h * 128 + lane * 2) = acc;
        __builtin_amdgcn_wave_barrier();
    }
}
__device__ void ph_merge(const Frame& F) {
    for (int r = F.bid * 8 + F.wave; r < NT; r += F.G * 8) {
#pragma unroll
        for (int g = 0; g < 2; ++g)
#pragma unroll
            for (int h = 0; h < 4; ++h) {
                const int c = h * 128 + F.lane * 2;
                float2 v;
                if (g == 0) { const float2 a = *(const float2*)(F.OGF + (size_t)r * 512 + c), bb = *(const float2*)(F.OGB + (size_t)r * 512 + c); v.x = a.x + bb.x; v.y = a.y + bb.y; }
                else v = *(const float2*)(F.OD + (size_t)r * 512 + c);
                const float ss = wave_sum(v.x * v.x + v.y * v.y);
                const float rstd = 1.0f / sqrtf(ss * (1.0f / 128.0f) + 1e-6f);
                const float* gain = (g == 0 ? F.gla_gain : F.diff_gain) + F.lane * 2;
                const float sc = g == 0 ? 1.0f : 0.8f;
                const float2 gt = *(const float2*)(F.P + (size_t)r * PW + C_GATE + g * 512 + c);
                float2 o; o.x = v.x * rstd * gain[0] * sc * silu_f(gt.x); o.y = v.y * rstd * gain[1] * sc * silu_f(gt.y);
                *(float2*)(F.MG + (size_t)r * D + g * 512 + c) = o;
            }
    }
}
__device__ void ph_final(const Frame& F) {
    for (int r = F.bid * 8 + F.wave; r < NT; r += F.G * 8) {
        float* y = F.out + (size_t)r * D;
        float4 v[4]; float ss = 0.f;
#pragma unroll
        for (int i = 0; i < 4; ++i) { v[i] = *(const float4*)(y + i * 256 + F.lane * 4); ss += v[i].x * v[i].x + v[i].y * v[i].y + v[i].z * v[i].z + v[i].w * v[i].w; }
        ss = wave_sum(ss);
        const float rstd = 1.0f / sqrtf(ss * (1.0f / 1024.0f) + 1e-6f);
#pragma unroll
        for (int i = 0; i < 4; ++i) {
            const int k = i * 256 + F.lane * 4; const float4 g = *(const float4*)(F.final_gain + k);
            float4 o; o.x = v[i].x * rstd * g.x; o.y = v[i].y * rstd * g.y; o.z = v[i].z * rstd * g.z; o.w = v[i].w * rstd * g.w;
            *(float4*)(y + k) = o;
        }
    }
}

__global__ void __launch_bounds__(NTHR, 2) mega(Args args) {
    extern __shared__ __attribute__((aligned(16))) unsigned char lds_raw[];
    LAS unsigned char* lds = (LAS unsigned char*)lds_raw;
    Frame F;
    F.x_prompt = args.in[0]; F.x_sample = args.in[1]; F.cache_k = args.in[2]; F.cache_v = args.in[3]; F.st_f = args.in[4]; F.st_b = args.in[5];
    F.c = args.in[6]; F.c_ctx = args.in[7]; F.norm_gain = args.in[8]; F.w_mod = args.in[9]; F.b_mod = args.in[10]; F.w_in = args.in[11];
    F.w_alpha = args.in[12]; F.b_alpha = args.in[13]; F.dlam = args.in[14]; F.gla_gain = args.in[15]; F.diff_gain = args.in[16]; F.w_out = args.in[17]; F.final_gain = args.in[18];
    F.out = args.out; F.ws = args.ws;
    F.MOD = (float*)(args.ws + WS_MOD); F.H = (float*)(args.ws + WS_H); F.P = (float*)(args.ws + WS_P);
    F.OGF = (float*)(args.ws + WS_OGF); F.OGB = (float*)(args.ws + WS_OGB); F.OD = (float*)(args.ws + WS_OD); F.MG = (float*)(args.ws + WS_MG);
    F.tid = threadIdx.x; F.lane = F.tid & 63; F.wave = F.tid >> 6; F.G = gridDim.x; F.bid = blockIdx.x;
    volatile LAS unsigned* misc = (volatile LAS unsigned*)(lds + LDS_BYTES - 64);
    if (F.tid < 16) misc[F.tid] = 0u;
    __syncthreads();
    const int lo = args.ph_lo, hi = args.ph_hi;
    XcdBarrier bar; bar.bar = (unsigned*)(args.ws + WS_CTL) + 1024; bar.x = 0; bar.st = nullptr;
    if (hi - lo > 1) bar = xcd_barrier_post((unsigned*)(args.ws + WS_CTL) + 1024, misc);
#define IN(k) (lo <= (k) && (k) < hi)
#define SEAM(k) do { if (IN(k) && IN((k) + 1)) xcd_barrier(bar); } while (0)
    LAS float* ldsf = (LAS float*)lds;
    if (IN(0)) { ph_mod(F); } SEAM(0);
    if (IN(1)) { ph_h(F); } SEAM(1);
    if (IN(2)) { EpiIn E{F.P, F.out}; gemm_naive(F, ldsf, F.H, D, F.w_in, PW, NT, PW, D, E); } SEAM(2);
    if (IN(3)) { ph_rope(F); } SEAM(3);
    if (IN(4)) { ph_gla(F, ldsf); __syncthreads(); ph_diff(F, ldsf); } SEAM(4);
    if (IN(5)) { ph_merge(F); } SEAM(5);
    if (IN(6)) { EpiOut E{&F}; gemm_naive(F, ldsf, F.MG, D, F.w_out, D, NT, D, D, E); } SEAM(6);
    if (IN(7)) { ph_final(F); }
#undef IN
#undef SEAM
}

extern "C" void kernel_launch(void* const* d_in, const int* in_sizes, int n_in, void* d_out, int out_size, void* d_ws, size_t ws_size, hipStream_t stream) {
    static int grid = 0;
    if (grid == 0) {
        if (n_in != 19 || out_size != 11534336 || ws_size < WS_END) { fprintf(stderr, "kernel_launch: unexpected shapes n_in %d out %d ws %zu\n", n_in, out_size, ws_size); grid = -1; return; }
        int dev = 0, cus = 0;
        if (hipGetDevice(&dev) != hipSuccess || hipDeviceGetAttribute(&cus, hipDeviceAttributeMultiprocessorCount, dev) != hipSuccess) { grid = -1; return; }
        if (hipFuncSetAttribute((const void*)mega, hipFuncAttributeMaxDynamicSharedMemorySize, LDS_BYTES) != hipSuccess) { fprintf(stderr, "kernel_launch: hipFuncSetAttribute failed\n"); grid = -1; return; }
        grid = cus;
    }
    if (grid < 0) return;
    (void)hipMemsetAsync((char*)d_ws + WS_CTL, 0, CTL_ZERO_BYTES, stream);
    Args a{};
    for (int i = 0; i < 19; ++i) a.in[i] = (const float*)d_in[i];
    a.out = (float*)d_out; a.ws = (unsigned char*)d_ws;
    constexpr int NPH = 8;
    if (MK_N_LAUNCHES == 1) {
        a.ph_lo = 0; a.ph_hi = NPH;
        hipLaunchKernelGGL(mega, dim3(grid), dim3(NTHR), LDS_BYTES, stream, a);
    } else {
        for (int p = 0; p < NPH; ++p) { a.ph_lo = p; a.ph_hi = p + 1; hipLaunchKernelGGL(mega, dim3(grid), dim3(NTHR), LDS_BYTES, stream, a); }
    }
}
```

```cpp
#include <hip/hip_runtime.h>
#include <cstdio>
#include <cstdint>

#ifndef MK_N_LAUNCHES
#define MK_N_LAUNCHES 1
#endif

constexpr int D = 1024, NPR = 4096, NSR = 2048, NT = 6144, PW = 3616;
constexpr int C_GQ = 0, C_GK = 256, C_GV = 512, C_LRF = 1024, C_LRB = 1040, C_DQ = 1056, C_DK = 1568, C_DV = 2080, C_GATE = 2592;
constexpr size_t O_Y = 0, O_NK = 6291456, O_NV = 8388608, O_SF = 10485760, O_SB = 11010048;
constexpr int NTHR = 512;
constexpr int LDS_BYTES = 147456;

constexpr size_t MiB = 1u << 20;
constexpr size_t WS_CTL = 0, CTL_ZERO_BYTES = 64 * 1024;
constexpr size_t WS_MOD = 1 * MiB;
constexpr size_t WS_H = 2 * MiB;
constexpr size_t WS_P = 26 * MiB;
constexpr size_t WS_OGF = 112 * MiB;
constexpr size_t WS_OGB = 124 * MiB;
constexpr size_t WS_OD = 136 * MiB;
constexpr size_t WS_MG = 148 * MiB;
constexpr size_t WS_END = 172 * MiB;

#define LAS __attribute__((address_space(3)))

#define XB_TMO      128
#define XB_XCNT(j)  (256  + 64 * (j))
#define XB_XSUB(j)  (1280 + 64 * (j))
#define XB_XGEN(j)  (2304 + 64 * (j))
#define XB_TOP      3328
#define XB_TOPGEN   3392
#define XCD_BAR_WORDS 3456
#define XB_SPIN_CAP (1u << 18)
__device__ __forceinline__ unsigned xb_ld(unsigned* p)              { return __hip_atomic_load(p, __ATOMIC_RELAXED, __HIP_MEMORY_SCOPE_AGENT); }
__device__ __forceinline__ unsigned xb_add(unsigned* p, unsigned v) { return __hip_atomic_fetch_add(p, v, __ATOMIC_RELAXED, __HIP_MEMORY_SCOPE_AGENT); }
__device__ __forceinline__ unsigned xb_xcc_id() { return (unsigned)__builtin_amdgcn_s_getreg((3 << 11) | 20) & 0xFu; }
#define XB_SPIN(cond, bar) do { unsigned _sp = 0; while (cond) { __builtin_amdgcn_s_sleep(1); \
    if ((++_sp & 255u) == 0u) { if (xb_ld(&(bar)[XB_TMO])) break; if (_sp > XB_SPIN_CAP) { atomicAdd(&(bar)[XB_TMO], 1u); break; } } } } while (0)
struct XcdBarrier { unsigned* bar; unsigned x; volatile LAS unsigned* st; };
__device__ __forceinline__ XcdBarrier xcd_barrier_post(unsigned* bar, volatile LAS unsigned* st) {
    XcdBarrier b; b.bar = bar; b.x = xb_xcc_id(); b.st = st;
    if (threadIdx.x == 0) (void)xb_add(&bar[XB_XCNT(b.x)], 1u);
    return b;
}
__device__ __forceinline__ void xcd_barrier_complete(unsigned* bar, unsigned x, unsigned& nloc, unsigned& nx) {
    const unsigned G = gridDim.x * gridDim.y * gridDim.z;
    unsigned sum, cnt, mine, sp = 0u;
    for (;;) {
        sum = 0u; cnt = 0u; mine = 0u;
#pragma unroll
        for (unsigned j = 0; j < 16; ++j) { const unsigned c = xb_ld(&bar[XB_XCNT(j)]); sum += c; cnt += (c > 0u) ? 1u : 0u; mine = (j == x) ? c : mine; }
        if (sum == G) break;
        __builtin_amdgcn_s_sleep(1);
        if ((++sp & 255u) == 0u) { if (xb_ld(&bar[XB_TMO])) break; if (sp > XB_SPIN_CAP) { atomicAdd(&bar[XB_TMO], 1u); break; } }
    }
    nloc = mine > 0u ? mine : 1u; nx = cnt > 0u ? cnt : 1u;
}
__device__ __forceinline__ void xcd_barrier(const XcdBarrier& b) {
    asm volatile("s_waitcnt vmcnt(0)" ::: "memory");
    __syncthreads();
    if (threadIdx.x == 0) {
        unsigned* bar = b.bar;
        __builtin_amdgcn_s_waitcnt(0);
        unsigned nloc = b.st[0], nx = b.st[1];
        if (nloc == 0u) { xcd_barrier_complete(bar, b.x, nloc, nx); b.st[0] = nloc; b.st[1] = nx; }
        const unsigned old = xb_add(&bar[XB_XSUB(b.x)], 1u);
        const unsigned gen = old / nloc;
        if (old + 1u == (gen + 1u) * nloc) {
            __builtin_amdgcn_fence(__ATOMIC_RELEASE, "agent");
            asm volatile("s_waitcnt vmcnt(0)" ::: "memory");
            const unsigned og = xb_add(&bar[XB_TOP], 1u);
            const unsigned tg = og / nx;
            if (og + 1u == (tg + 1u) * nx) xb_add(&bar[XB_TOPGEN], 1u);
            else XB_SPIN(xb_ld(&bar[XB_TOPGEN]) == tg, bar);
            __builtin_amdgcn_fence(__ATOMIC_ACQUIRE, "agent");
            xb_add(&bar[XB_XGEN(b.x)], 1u);
            asm volatile("s_waitcnt vmcnt(0)" ::: "memory");
        } else {
            XB_SPIN(xb_ld(&bar[XB_XGEN(b.x)]) == gen, bar);
            __builtin_amdgcn_fence(__ATOMIC_ACQUIRE, "agent");
            asm volatile("s_waitcnt vmcnt(0)" ::: "memory");
        }
    }
    __syncthreads();
}

struct Args {
    const float* in[19]; float* out; unsigned char* ws; int ph_lo, ph_hi;
};
struct Frame {
    const float *x_prompt, *x_sample, *cache_k, *cache_v, *st_f, *st_b, *c, *c_ctx, *norm_gain, *w_mod, *b_mod, *w_in, *w_alpha, *b_alpha, *dlam, *gla_gain, *diff_gain, *w_out, *final_gain;
    float* out; unsigned char* ws;
    float *MOD, *H, *P, *OGF, *OGB, *OD, *MG;
    int tid, lane, wave, G, bid;
};
__device__ __forceinline__ float wave_sum(float v) {
#pragma unroll
    for (int o = 32; o > 0; o >>= 1) v += __shfl_xor(v, o);
    return v;
}
__device__ __forceinline__ float wave_max(float v) {
#pragma unroll
    for (int o = 32; o > 0; o >>= 1) v = fmaxf(v, __shfl_xor(v, o));
    return v;
}
__device__ __forceinline__ float silu_f(float x) { return x / (1.0f + expf(-x)); }
__device__ __forceinline__ const float* xrow(const Frame& F, int r) { return r < NPR ? F.x_prompt + (size_t)r * D : F.x_sample + (size_t)(r - NPR) * D; }
__device__ __forceinline__ int variant_of(int r) { return r < NPR ? 0 : 1 + (r - NPR) / 1024; }
__device__ __forceinline__ float lam_value(const Frame& F) {
    float a = 0.f, b = 0.f;
    for (int i = 0; i < 64; ++i) { a += F.dlam[i] * F.dlam[64 + i]; b += F.dlam[128 + i] * F.dlam[192 + i]; }
    return expf(a) - expf(b) + 0.2f;
}

__device__ void ph_mod(const Frame& F) {
    for (int e = F.bid * NTHR + F.tid; e < 3072; e += F.G * NTHR) {
        float a0 = 0.f, a1 = 0.f, a2 = 0.f;
        for (int d = 0; d < D; ++d) {
            const float w = F.w_mod[(size_t)d * 3072 + e];
            a0 += silu_f(F.c_ctx[d]) * w; a1 += silu_f(F.c[d]) * w; a2 += silu_f(F.c[D + d]) * w;
        }
        const float bb = F.b_mod[e];
        F.MOD[e] = a0 + bb; F.MOD[3072 + e] = a1 + bb; F.MOD[6144 + e] = a2 + bb;
    }
}
__device__ void ph_h(const Frame& F) {
    for (int r = F.bid * 8 + F.wave; r < NT; r += F.G * 8) {
        const float* x = xrow(F, r); const float* m = F.MOD + variant_of(r) * 3072;
        float4 v[4]; float ss = 0.f;
#pragma unroll
        for (int i = 0; i < 4; ++i) { v[i] = *(const float4*)(x + i * 256 + F.lane * 4); ss += v[i].x * v[i].x + v[i].y * v[i].y + v[i].z * v[i].z + v[i].w * v[i].w; }
        ss = wave_sum(ss);
        const float rstd = 1.0f / sqrtf(ss * (1.0f / 1024.0f) + 1e-6f);
#pragma unroll
        for (int i = 0; i < 4; ++i) {
            const int k = i * 256 + F.lane * 4;
            const float4 g = *(const float4*)(F.norm_gain + k), sh = *(const float4*)(m + k), sc = *(const float4*)(m + 1024 + k);
            float4 o;
            o.x = v[i].x * rstd * g.x * (1.0f + sc.x) + sh.x; o.y = v[i].y * rstd * g.y * (1.0f + sc.y) + sh.y;
            o.z = v[i].z * rstd * g.z * (1.0f + sc.z) + sh.z; o.w = v[i].w * rstd * g.w * (1.0f + sc.w) + sh.w;
            *(float4*)(F.H + (size_t)r * D + k) = o;
        }
    }
}
template <class Epi>
__device__ void gemm_naive(const Frame& F, LAS float* lds, const float* A, int lda, const float* B, int ldb, int M, int N, int K, const Epi& E) {
    LAS float* As = lds;
    LAS float* Bs = lds + 16 * 132;
    const int ntn = (N + 63) / 64, ntm = M / 128, nt = ntn * ntm;
    const int tid = F.tid, ty = tid >> 4, tx = tid & 15;
    for (int t = F.bid; t < nt; t += F.G) {
        const int tm = t / ntn, tn = t % ntn, row0 = tm * 128, col0 = tn * 64;
        float acc[4][4];
#pragma unroll
        for (int i = 0; i < 4; ++i)
#pragma unroll
            for (int j = 0; j < 4; ++j) acc[i][j] = 0.f;
        for (int k0 = 0; k0 < K; k0 += 16) {
            { const int r = tid >> 2, kq = (tid & 3) * 4; const float4 a = *(const float4*)(A + (size_t)(row0 + r) * lda + k0 + kq);
              As[(kq + 0) * 132 + r] = a.x; As[(kq + 1) * 132 + r] = a.y; As[(kq + 2) * 132 + r] = a.z; As[(kq + 3) * 132 + r] = a.w; }
            { const int k = tid >> 5, c = (tid & 31) * 2; float2 b = make_float2(0.f, 0.f); if (col0 + c < N) b = *(const float2*)(B + (size_t)(k0 + k) * ldb + col0 + c);
              Bs[k * 64 + c] = b.x; Bs[k * 64 + c + 1] = b.y; }
            __syncthreads();
#pragma unroll
            for (int kk = 0; kk < 16; ++kk) {
                float a[4], b[4];
#pragma unroll
                for (int i = 0; i < 4; ++i) { a[i] = As[kk * 132 + ty * 4 + i]; b[i] = Bs[kk * 64 + tx * 4 + i]; }
#pragma unroll
                for (int i = 0; i < 4; ++i)
#pragma unroll
                    for (int j = 0; j < 4; ++j) acc[i][j] += a[i] * b[j];
            }
            __syncthreads();
        }
#pragma unroll
        for (int i = 0; i < 4; ++i)
#pragma unroll
            for (int j = 0; j < 4; ++j) { const int r = row0 + ty * 4 + i, c = col0 + tx * 4 + j; if (c < N) E(r, c, acc[i][j]); }
    }
}
struct EpiIn { float* P; float* out;
    __device__ __forceinline__ void operator()(int r, int c, float v) const {
        P[(size_t)r * PW + c] = v;
        if (r < NPR) { if (c >= C_DK && c < C_DV) out[O_NK + (size_t)r * 512 + (c - C_DK)] = v; else if (c >= C_DV && c < C_GATE) out[O_NV + (size_t)r * 512 + (c - C_DV)] = v; }
    } };
struct EpiOut { const Frame* F;
    __device__ __forceinline__ void operator()(int r, int c, float v) const {
        const float gt = F->MOD[variant_of(r) * 3072 + 2048 + c];
        F->out[(size_t)r * D + c] = xrow(*F, r)[c] + gt * v;
    } };
__device__ void ph_rope(const Frame& F) {
    const long total = (long)NSR * 512;
    for (long idx = (long)F.bid * NTHR + F.tid; idx < total; idx += (long)F.G * NTHR) {
        const int p = (int)(idx & 31), vec = (int)((idx >> 5) & 7), which = (int)((idx >> 8) & 1), rs = (int)(idx >> 9);
        const int t = rs & 1023, gr = t >> 6, gc = t & 63;
        const int i = p & 15; const int pos = p < 16 ? gr : gc; const int d1 = (p < 16 ? 0 : 32) + i, d2 = d1 + 16;
        const float inv = powf(10000.0f, -(float)i / 16.0f);
        const float ang = (float)pos * inv, cs = cosf(ang), sn = sinf(ang);
        float* base = F.P + (size_t)(NPR + rs) * PW + (which ? C_DK : C_DQ) + vec * 64;
        const float v1 = base[d1], v2 = base[d2];
        base[d1] = v1 * cs - v2 * sn; base[d2] = v1 * sn + v2 * cs;
    }
}
__device__ __forceinline__ float log_sigmoid_f(float z) { return fminf(z, 0.f) - log1pf(expf(-fabsf(z))); }
__device__ void ph_gla(const Frame& F, LAS float* lds) {
    LAS float* al = lds;
    LAS float* qs = al + 4096;
    LAS float* ks = qs + 4096;
    LAS float* vs = ks + 4096;
    LAS float* po = vs + 8192;
    const int tid = F.tid, j = tid & 127, kq = tid >> 7;
    for (int item = F.bid; item < 144; item += F.G) {
        int grp, b, h, dir;
        if (item < 128) { grp = 0; b = item >> 3; h = (item >> 1) & 3; dir = item & 1; } else { const int it = item - 128; grp = 1; b = it >> 3; h = (it >> 1) & 3; dir = it & 1; }
        const int R0 = grp == 0 ? b * 256 : NPR + b * 1024, n = grp == 0 ? 256 : 1024;
        float S[16];
        if (grp == 0) {
#pragma unroll
            for (int i = 0; i < 16; ++i) S[i] = 0.f;
        } else {
            const float* st = (dir == 0 ? F.st_f : F.st_b) + (size_t)(b * 4 + h) * 64 * 128;
#pragma unroll
            for (int i = 0; i < 16; ++i) S[i] = st[(kq * 16 + i) * 128 + j];
        }
        float* OG = dir == 0 ? F.OGF : F.OGB;
        for (int c0 = 0; c0 < n; c0 += 64) {
            __syncthreads();
            for (int e = tid; e < 4096; e += NTHR) {
                const int s = e >> 6, k = e & 63; const int t = dir == 0 ? c0 + s : n - 1 - (c0 + s); const float* prow = F.P + (size_t)(R0 + t) * PW;
                float z = F.b_alpha[dir * 256 + h * 64 + k];
                for (int r = 0; r < 16; ++r) z += prow[(dir == 0 ? C_LRF : C_LRB) + r] * F.w_alpha[(size_t)(dir * 16 + r) * 256 + h * 64 + k];
                al[e] = expf(log_sigmoid_f(z) * (1.0f / 16.0f));
                qs[e] = prow[C_GQ + h * 64 + k] * 0.125f;
                ks[e] = prow[C_GK + h * 64 + k];
            }
            for (int e = tid; e < 8192; e += NTHR) {
                const int s = e >> 7, jj = e & 127; const int t = dir == 0 ? c0 + s : n - 1 - (c0 + s);
                vs[e] = F.P[(size_t)(R0 + t) * PW + C_GV + h * 128 + jj];
            }
            __syncthreads();
            for (int s = 0; s < 64; ++s) {
                const float v = vs[s * 128 + j]; float o = 0.f;
#pragma unroll
                for (int i = 0; i < 16; ++i) { const int k = kq * 16 + i; S[i] = al[s * 64 + k] * S[i] + ks[s * 64 + k] * v; o += qs[s * 64 + k] * S[i]; }
                po[((s & 1) * 4 + kq) * 128 + j] = o;
                __syncthreads();
                if (kq == 0) {
                    const int t = dir == 0 ? c0 + s : n - 1 - (c0 + s);
                    const int pb = (s & 1) * 4;
                    OG[(size_t)(R0 + t) * 512 + h * 128 + j] = po[(pb + 0) * 128 + j] + po[(pb + 1) * 128 + j] + po[(pb + 2) * 128 + j] + po[(pb + 3) * 128 + j];
                }
            }
        }
        if (grp == 0) {
            float* so = F.out + (dir == 0 ? O_SF : O_SB) + (size_t)(b * 4 + h) * 64 * 128;
#pragma unroll
            for (int i = 0; i < 16; ++i) so[(kq * 16 + i) * 128 + j] = S[i];
        }
    }
}
__device__ void ph_diff(const Frame& F, LAS float* lds) {
    LAS float* wl = lds + F.wave * 3328;
    LAS float* qb = wl; LAS float* s1 = wl + 128; LAS float* s2 = s1 + 1536;
    const float lam = lam_value(F);
    const int lane = F.lane;
    for (int item = F.bid * 8 + F.wave; item < NT * 4; item += F.G * 8) {
        const int r = item >> 2, h = item & 3;
        int R0, nc, nk, b;
        if (r < NPR) { b = r >> 8; R0 = b * 256; nc = 0; nk = 256; } else { b = (r - NPR) >> 10; R0 = NPR + b * 1024; nc = 512; nk = 1536; }
        const float* qp = F.P + (size_t)r * PW + C_DQ + h * 128;
        qb[lane] = qp[lane]; qb[64 + lane] = qp[64 + lane];
        __builtin_amdgcn_wave_barrier();
        float m1 = -3.0e38f, m2 = -3.0e38f;
        for (int jk = lane; jk < nk; jk += 64) {
            const float* kp = jk < nc ? F.cache_k + ((size_t)(b * 512 + jk) * 4 + h) * 128 : F.P + (size_t)(R0 + jk - nc) * PW + C_DK + h * 128;
            float a1 = 0.f, a2 = 0.f;
            for (int d = 0; d < 64; d += 4) {
                const float4 k1 = *(const float4*)(kp + d), k2 = *(const float4*)(kp + 64 + d);
                a1 += qb[d] * k1.x + qb[d + 1] * k1.y + qb[d + 2] * k1.z + qb[d + 3] * k1.w;
                a2 += qb[64 + d] * k2.x + qb[64 + d + 1] * k2.y + qb[64 + d + 2] * k2.z + qb[64 + d + 3] * k2.w;
            }
            a1 *= 0.125f; a2 *= 0.125f; s1[jk] = a1; s2[jk] = a2; m1 = fmaxf(m1, a1); m2 = fmaxf(m2, a2);
        }
        m1 = wave_max(m1); m2 = wave_max(m2);
        float l1 = 0.f, l2 = 0.f;
        for (int jk = lane; jk < nk; jk += 64) { const float e1 = expf(s1[jk] - m1), e2 = expf(s2[jk] - m2); s1[jk] = e1; s2[jk] = e2; l1 += e1; l2 += e2; }
        l1 = wave_sum(l1); l2 = wave_sum(l2);
        const float i1 = 1.0f / l1, i2 = lam / l2;
        for (int jk = lane; jk < nk; jk += 64) s1[jk] = s1[jk] * i1 - s2[jk] * i2;
        __builtin_amdgcn_wave_barrier();
        float2 acc = make_float2(0.f, 0.f);
        for (int jk = 0; jk < nk; ++jk) {
            const float* vp = jk < nc ? F.cache_v + ((size_t)(b * 512 + jk) * 4 + h) * 128 : F.P + (size_t)(R0 + jk - nc) * PW + C_DV + h * 128;
            const float a = s1[jk]; const float2 v = *(const float2*)(vp + lane * 2);
            acc.x += a * v.x; acc.y += a * v.y;
        }
        *(float2*)(F.OD + (size_t)r * 512 + h * 128 + lane * 2) = acc;
        __builtin_amdgcn_wave_barrier();
    }
}
__device__ void ph_merge(const Frame& F) {
    for (int r = F.bid * 8 + F.wave; r < NT; r += F.G * 8) {
#pragma unroll
        for (int g = 0; g < 2; ++g)
#pragma unroll
            for (int h = 0; h < 4; ++h) {
                const int c = h * 128 + F.lane * 2;
                float2 v;
                if (g == 0) { const float2 a = *(const float2*)(F.OGF + (size_t)r * 512 + c), bb = *(const float2*)(F.OGB + (size_t)r * 512 + c); v.x = a.x + bb.x; v.y = a.y + bb.y; }
                else v = *(const float2*)(F.OD + (size_t)r * 512 + c);
                const float ss = wave_sum(v.x * v.x + v.y * v.y);
                const float rstd = 1.0f / sqrtf(ss * (1.0f / 128.0f) + 1e-6f);
                const float* gain = (g == 0 ? F.gla_gain : F.diff_gain) + F.lane * 2;
                const float sc = g == 0 ? 1.0f : 0.8f;
                const float2 gt = *(const float2*)(F.P + (size_t)r * PW + C_GATE + g * 512 + c);
                float2 o; o.x = v.x * rstd * gain[0] * sc * silu_f(gt.x); o.y = v.y * rstd * gain[1] * sc * silu_f(gt.y);
                *(float2*)(F.MG + (size_t)r * D + g * 512 + c) = o;
            }
    }
}
__device__ void ph_final(const Frame& F) {
    for (int r = F.bid * 8 + F.wave; r < NT; r += F.G * 8) {
        float* y = F.out + (size_t)r * D;
        float4 v[4]; float ss = 0.f;
#pragma unroll
        for (int i = 0; i < 4; ++i) { v[i] = *(const float4*)(y + i * 256 + F.lane * 4); ss += v[i].x * v[i].x + v[i].y * v[i].y + v[i].z * v[i].z + v[i].w * v[i].w; }
        ss = wave_sum(ss);
        const float rstd = 1.0f / sqrtf(ss * (1.0f / 1024.0f) + 1e-6f);
#pragma unroll
        for (int i = 0; i < 4; ++i) {
            const int k = i * 256 + F.lane * 4; const float4 g = *(const float4*)(F.final_gain + k);
            float4 o; o.x = v[i].x * rstd * g.x; o.y = v[i].y * rstd * g.y; o.z = v[i].z * rstd * g.z; o.w = v[i].w * rstd * g.w;
            *(float4*)(y + k) = o;
        }
    }
}

__global__ void __launch_bounds__(NTHR, 2) mega(Args args) {
    extern __shared__ __attribute__((aligned(16))) unsigned char lds_raw[];
    LAS unsigned char* lds = (LAS unsigned char*)lds_raw;
    Frame F;
    F.x_prompt = args.in[0]; F.x_sample = args.in[1]; F.cache_k = args.in[2]; F.cache_v = args.in[3]; F.st_f = args.in[4]; F.st_b = args.in[5];
    F.c = args.in[6]; F.c_ctx = args.in[7]; F.norm_gain = args.in[8]; F.w_mod = args.in[9]; F.b_mod = args.in[10]; F.w_in = args.in[11];
    F.w_alpha = args.in[12]; F.b_alpha = args.in[13]; F.dlam = args.in[14]; F.gla_gain = args.in[15]; F.diff_gain = args.in[16]; F.w_out = args.in[17]; F.final_gain = args.in[18];
    F.out = args.out; F.ws = args.ws;
    F.MOD = (float*)(args.ws + WS_MOD); F.H = (float*)(args.ws + WS_H); F.P = (float*)(args.ws + WS_P);
    F.OGF = (float*)(args.ws + WS_OGF); F.OGB = (float*)(args.ws + WS_OGB); F.OD = (float*)(args.ws + WS_OD); F.MG = (float*)(args.ws + WS_MG);
    F.tid = threadIdx.x; F.lane = F.tid & 63; F.wave = F.tid >> 6; F.G = gridDim.x; F.bid = blockIdx.x;
    volatile LAS unsigned* misc = (volatile LAS unsigned*)(lds + LDS_BYTES - 64);
    if (F.tid < 16) misc[F.tid] = 0u;
    __syncthreads();
    const int lo = args.ph_lo, hi = args.ph_hi;
    XcdBarrier bar; bar.bar = (unsigned*)(args.ws + WS_CTL) + 1024; bar.x = 0; bar.st = nullptr;
    if (hi - lo > 1) bar = xcd_barrier_post((unsigned*)(args.ws + WS_CTL) + 1024, misc);
#define IN(k) (lo <= (k) && (k) < hi)
#define SEAM(k) do { if (IN(k) && IN((k) + 1)) xcd_barrier(bar); } while (0)
    LAS float* ldsf = (LAS float*)lds;
    if (IN(0)) { ph_mod(F); } SEAM(0);
    if (IN(1)) { ph_h(F); } SEAM(1);
    if (IN(2)) { EpiIn E{F.P, F.out}; gemm_naive(F, ldsf, F.H, D, F.w_in, PW, NT, PW, D, E); } SEAM(2);
    if (IN(3)) { ph_rope(F); } SEAM(3);
    if (IN(4)) { ph_gla(F, ldsf); __syncthreads(); ph_diff(F, ldsf); } SEAM(4);
    if (IN(5)) { ph_merge(F); } SEAM(5);
    if (IN(6)) { EpiOut E{&F}; gemm_naive(F, ldsf, F.MG, D, F.w_out, D, NT, D, D, E); } SEAM(6);
    if (IN(7)) { ph_final(F); }
#undef IN
#undef SEAM
}

extern "C" void kernel_launch(void* const* d_in, const int* in_sizes, int n_in, void* d_out, int out_size, void* d_ws, size_t ws_size, hipStream_t stream) {
    static int grid = 0;
    if (grid == 0) {
        if (n_in != 19 || out_size != 11534336 || ws_size < WS_END) { fprintf(stderr, "kernel_launch: unexpected shapes n_in %d out %d ws %zu\n", n_in, out_size, ws_size); grid = -1; return; }
        int dev = 0, cus = 0;
        if (hipGetDevice(&dev) != hipSuccess || hipDeviceGetAttribute(&cus, hipDeviceAttributeMultiprocessorCount, dev) != hipSuccess) { grid = -1; return; }
        if (hipFuncSetAttribute((const void*)mega, hipFuncAttributeMaxDynamicSharedMemorySize, LDS_BYTES) != hipSuccess) { fprintf(stderr, "kernel_launch: hipFuncSetAttribute failed\n"); grid = -1; return; }
        grid = cus;
    }
    if (grid < 0) return;
    (void)hipMemsetAsync((char*)d_ws + WS_CTL, 0, CTL_ZERO_BYTES, stream);
    Args a{};
    for (int i = 0; i < 19; ++i) a.in[i] = (const float*)d_in[i];
    a.out = (float*)d_out; a.ws = (unsigned char*)d_ws;
    constexpr int NPH = 8;
    if (MK_N_LAUNCHES == 1) {
        a.ph_lo = 0; a.ph_hi = NPH;
        hipLaunchKernelGGL(mega, dim3(grid), dim3(NTHR), LDS_BYTES, stream, a);
    } else {
        for (int p = 0; p < NPH; ++p) { a.ph_lo = p; a.ph_hi = p + 1; hipLaunchKernelGGL(mega, dim3(grid), dim3(NTHR), LDS_BYTES, stream, a); }
    }
}
```

```cpp
#include <hip/hip_runtime.h>
#include <cstdio>
#include <cstdint>

#ifndef MK_N_LAUNCHES
#define MK_N_LAUNCHES 1
#endif

constexpr int D = 1024, NPR = 4096, NSR = 2048, NT = 6144, PW = 3616;
constexpr int C_GQ = 0, C_GK = 256, C_GV = 512, C_LRF = 1024, C_LRB = 1040, C_DQ = 1056, C_DK = 1568, C_DV = 2080, C_GATE = 2592;
constexpr size_t O_Y = 0, O_NK = 6291456, O_NV = 8388608, O_SF = 10485760, O_SB = 11010048;
constexpr int NTHR = 512;
constexpr int LDS_BYTES = 147456;

constexpr size_t MiB = 1u << 20;
constexpr size_t WS_CTL = 0, CTL_ZERO_BYTES = 64 * 1024;
constexpr size_t WS_MOD = 24576;
constexpr size_t WS_ROPE = 64 * 1024;
constexpr size_t WS_WINT = 1 * MiB;
constexpr size_t WS_WOT = 9 * MiB;
constexpr size_t WS_HB = 12 * MiB;
constexpr size_t WS_QG = 24 * MiB, WS_KG = 27 * MiB;
constexpr size_t WS_VG = 30 * MiB;
constexpr size_t WS_DQ = 36 * MiB;
constexpr size_t WS_DKP = 42 * MiB, WS_DVP = 46 * MiB;
constexpr size_t WS_DKS = 50 * MiB, WS_DVS = 53 * MiB;
constexpr size_t WS_SG = 56 * MiB;
constexpr size_t WS_LR = 68 * MiB;
constexpr size_t WS_MGB = 70 * MiB;
constexpr size_t WS_VGT = 82 * MiB;
constexpr size_t WS_GSC = 90 * MiB;
constexpr size_t WS_P = 84 * MiB;
constexpr size_t WS_OGF = 170 * MiB;
constexpr size_t WS_OGB = 182 * MiB;
constexpr size_t WS_OD = 194 * MiB;
constexpr size_t WS_MG = 206 * MiB;
constexpr size_t WS_END = 230 * MiB;
constexpr int NIN = 3840;

#define LAS __attribute__((address_space(3)))

#define XB_TMO      128
#define XB_XCNT(j)  (256  + 64 * (j))
#define XB_XSUB(j)  (1280 + 64 * (j))
#define XB_XGEN(j)  (2304 + 64 * (j))
#define XB_TOP      3328
#define XB_TOPGEN   3392
#define XCD_BAR_WORDS 3456
#define XB_SPIN_CAP (1u << 18)
__device__ __forceinline__ unsigned xb_ld(unsigned* p)              { return __hip_atomic_load(p, __ATOMIC_RELAXED, __HIP_MEMORY_SCOPE_AGENT); }
__device__ __forceinline__ unsigned xb_add(unsigned* p, unsigned v) { return __hip_atomic_fetch_add(p, v, __ATOMIC_RELAXED, __HIP_MEMORY_SCOPE_AGENT); }
__device__ __forceinline__ unsigned xb_xcc_id() { return (unsigned)__builtin_amdgcn_s_getreg((3 << 11) | 20) & 0xFu; }
#define XB_SPIN(cond, bar) do { unsigned _sp = 0; while (cond) { __builtin_amdgcn_s_sleep(1); \
    if ((++_sp & 255u) == 0u) { if (xb_ld(&(bar)[XB_TMO])) break; if (_sp > XB_SPIN_CAP) { atomicAdd(&(bar)[XB_TMO], 1u); break; } } } } while (0)
struct XcdBarrier { unsigned* bar; unsigned x; volatile LAS unsigned* st; };
__device__ __forceinline__ XcdBarrier xcd_barrier_post(unsigned* bar, volatile LAS unsigned* st) {
    XcdBarrier b; b.bar = bar; b.x = xb_xcc_id(); b.st = st;
    if (threadIdx.x == 0) (void)xb_add(&bar[XB_XCNT(b.x)], 1u);
    return b;
}
__device__ __forceinline__ void xcd_barrier_complete(unsigned* bar, unsigned x, unsigned& nloc, unsigned& nx) {
    const unsigned G = gridDim.x * gridDim.y * gridDim.z;
    unsigned sum, cnt, mine, sp = 0u;
    for (;;) {
        sum = 0u; cnt = 0u; mine = 0u;
#pragma unroll
        for (unsigned j = 0; j < 16; ++j) { const unsigned c = xb_ld(&bar[XB_XCNT(j)]); sum += c; cnt += (c > 0u) ? 1u : 0u; mine = (j == x) ? c : mine; }
        if (sum == G) break;
        __builtin_amdgcn_s_sleep(1);
        if ((++sp & 255u) == 0u) { if (xb_ld(&bar[XB_TMO])) break; if (sp > XB_SPIN_CAP) { atomicAdd(&bar[XB_TMO], 1u); break; } }
    }
    nloc = mine > 0u ? mine : 1u; nx = cnt > 0u ? cnt : 1u;
}
__device__ __forceinline__ void xcd_barrier(const XcdBarrier& b) {
    asm volatile("s_waitcnt vmcnt(0)" ::: "memory");
    __syncthreads();
    if (threadIdx.x == 0) {
        unsigned* bar = b.bar;
        __builtin_amdgcn_s_waitcnt(0);
        unsigned nloc = b.st[0], nx = b.st[1];
        if (nloc == 0u) { xcd_barrier_complete(bar, b.x, nloc, nx); b.st[0] = nloc; b.st[1] = nx; }
        const unsigned old = xb_add(&bar[XB_XSUB(b.x)], 1u);
        const unsigned gen = old / nloc;
        if (old + 1u == (gen + 1u) * nloc) {
            __builtin_amdgcn_fence(__ATOMIC_RELEASE, "agent");
            asm volatile("s_waitcnt vmcnt(0)" ::: "memory");
            const unsigned og = xb_add(&bar[XB_TOP], 1u);
            const unsigned tg = og / nx;
            if (og + 1u == (tg + 1u) * nx) xb_add(&bar[XB_TOPGEN], 1u);
            else XB_SPIN(xb_ld(&bar[XB_TOPGEN]) == tg, bar);
            __builtin_amdgcn_fence(__ATOMIC_ACQUIRE, "agent");
            xb_add(&bar[XB_XGEN(b.x)], 1u);
            asm volatile("s_waitcnt vmcnt(0)" ::: "memory");
        } else {
            XB_SPIN(xb_ld(&bar[XB_XGEN(b.x)]) == gen, bar);
            __builtin_amdgcn_fence(__ATOMIC_ACQUIRE, "agent");
            asm volatile("s_waitcnt vmcnt(0)" ::: "memory");
        }
    }
    __syncthreads();
}

namespace pg8 {
#define PG8_LAS __attribute__((address_space(3)))
typedef unsigned short bf16_t;
typedef short bf16x8 __attribute__((ext_vector_type(8)));
typedef float f32x4 __attribute__((ext_vector_type(4)));
typedef unsigned u32x4 __attribute__((ext_vector_type(4)));
constexpr int BM = 256, BK = 64, HALF = 128, HTB = HALF * BK * 2  , STAGE_BYTES = 8 * HTB, NXCD = 8, WGM = 8;

__host__ __device__ __forceinline__ int lds_byte(int r, int c) { const int st = (r >> 4) * 2 + (c >> 5), rr = r & 15, cc = c & 31, ob = rr * 64 + cc * 2; return st * 1024 + (ob ^ (((ob >> 9) & 1) << 5)); }
__host__ __device__ __forceinline__ void stage_rc(int b, int& R, int& C) { const int st = b / 1024, sb = b % 1024, swz = sb ^ (((sb >> 9) & 1) << 5); R = (st >> 1) * 16 + swz / 64; C = (st & 1) * 32 + (swz % 64) / 2; }
__host__ __device__ __forceinline__ int perm32(int rho) { const int n = rho >> 4, i = rho & 15; return 8 * (i >> 2) + 4 * n + (i & 3); }

struct Unit { int pm, pn; };
struct Gemm { const bf16_t* A; const bf16_t* Bt; int M, N, K; };

struct StaticOrder {
    int nM, nN, nwg, G, c;
    __host__ __device__ void init(int M, int N, int G_, int c_) { nM = M / BM; nN = N / BM; nwg = nM * nN; G = G_; c = c_; }
    __host__ __device__ bool next(int i, Unit& u) const {
        const long L = (long)i * G + c; if (L >= nwg) return false;
        int wgid = (int)L; { const int q = nwg / NXCD, r = nwg % NXCD, xcd = wgid % NXCD, off = wgid / NXCD; wgid = (xcd < r ? xcd * (q + 1) : r * (q + 1) + (xcd - r) * q) + off; }
        const int nig = WGM * nN, gid = wgid / nig, fm = gid * WGM, gsz = (nM - fm) < WGM ? (nM - fm) : WGM;
        u.pm = fm + ((wgid % nig) % gsz); u.pn = (wgid % nig) / gsz; return true;
    }
    __device__ __forceinline__ void a_ready(const Unit&) const {}
    __device__ __forceinline__ void done(const Unit&) const {}
};

__device__ __forceinline__ unsigned cvt_pk_bf16(float lo, float hi) { unsigned r; asm volatile("v_cvt_pk_bf16_f32 %0, %1, %2" : "=v"(r) : "v"(lo), "v"(hi)); return r; }
template <class Epi, class Sched, bool ALIGN_EPI = false, bool SP2 = false>
__device__ __forceinline__ void gemm_phase(PG8_LAS unsigned char* lds, const Gemm g, const Sched& S, const Epi& E) {
    const int tid = threadIdx.x, wid = __builtin_amdgcn_readfirstlane(tid >> 6), lane = tid & 63, wr = wid >> 2, wc = wid & 3, fr = lane & 15, fq = lane >> 4;
    const int K = g.K, nt = K / BK;
    unsigned voffA[2], voffB[2];
#pragma unroll
    for (int i = 0; i < 2; ++i) { int R, C; stage_rc(tid * 16 + i * 8192, R, C); const int Rb = Epi::PERM ? ((R & ~31) + perm32(R & 31)) : R;
        voffA[i] = (unsigned)(R * K + C) * 2u; voffB[i] = (unsigned)(Rb * K + C) * 2u; }
    const size_t kstep = (size_t)(BK * 2);
    const size_t hstep = (size_t)HALF * K * 2;
    const size_t tstep = 2 * hstep;
    const unsigned ldsw = (unsigned)wid * 1024u;
    const int aoff = lds_byte(wr * 64 + fr, fq * 8), boff = lds_byte(wc * 32 + fr, fq * 8);
#define PG8_SA(b, h) (((b) * 2 + (h)) * HTB)
#define PG8_SB(b, h) ((4 + (b) * 2 + (h)) * HTB)
#define PG8_STAGE(bufoff, gbase, voff) do { _Pragma("unroll") for (int _i = 0; _i < 2; ++_i) \
        __builtin_amdgcn_global_load_lds((const unsigned*)((const char*)(gbase) + (voff)[_i]), (PG8_LAS unsigned*)(lds + (bufoff) + ldsw + _i * 8192), 16, 0, 0); } while (0)
#define PG8_LDA(dst, b, h) do { _Pragma("unroll") for (int m = 0; m < 4; ++m) _Pragma("unroll") for (int k = 0; k < 2; ++k) dst[m][k] = *(const PG8_LAS bf16x8*)(lds + PG8_SA(b, h) + aoff + m * 2048 + k * 1024); } while (0)
#define PG8_LDB(dst, b, h) do { _Pragma("unroll") for (int n = 0; n < 2; ++n) _Pragma("unroll") for (int k = 0; k < 2; ++k) dst[n][k] = *(const PG8_LAS bf16x8*)(lds + PG8_SB(b, h) + boff + n * 2048 + k * 1024); } while (0)
#define PG8_MMA(ai, bj, At, Bt) do { __builtin_amdgcn_s_setprio(1); _Pragma("unroll") for (int m = 0; m < 4; ++m) _Pragma("unroll") for (int n = 0; n < 2; ++n) _Pragma("unroll") for (int k = 0; k < 2; ++k) \
        acc[ai][bj][m][n] = __builtin_amdgcn_mfma_f32_16x16x32_bf16(Bt[n][k], At[m][k], acc[ai][bj][m][n], 0, 0, 0); __builtin_amdgcn_s_setprio(0); } while (0)
#define PG8_WAIT_V(n) asm volatile("s_waitcnt vmcnt(" #n ")" ::: "memory")
#define PG8_WAIT_L(n) asm volatile("s_waitcnt lgkmcnt(" #n ")" ::: "memory")
#define PG8_BAR __builtin_amdgcn_s_barrier()
#define PG8_SCHED __builtin_amdgcn_sched_barrier(0)
    Unit cur, nxt; int ui = 0;
    if (!S.next(0, cur)) return;
    f32x4 acc[2][2][4][2];
#pragma unroll
    for (int a = 0; a < 2; ++a)
#pragma unroll
        for (int b = 0; b < 2; ++b)
#pragma unroll
            for (int m = 0; m < 4; ++m)
#pragma unroll
                for (int n = 0; n < 2; ++n) acc[a][b][m][n] = (f32x4){0.f, 0.f, 0.f, 0.f};
    bf16x8 At[4][2], B0[2][2], B1[2][2];
    const char* cA = (const char*)g.A + (size_t)cur.pm * tstep; const char* cB = (const char*)g.Bt + (size_t)cur.pn * tstep;
    S.a_ready(cur);
    if constexpr (SP2) {
        PG8_STAGE(PG8_SB(0, 0), cB, voffB); PG8_STAGE(PG8_SB(0, 1), cB + hstep, voffB); PG8_STAGE(PG8_SA(0, 0), cA, voffA); PG8_STAGE(PG8_SA(0, 1), cA + hstep, voffA);
        if (wr == 1) PG8_BAR;
        PG8_WAIT_V(2); PG8_BAR;
        PG8_STAGE(PG8_SB(1, 0), cB + kstep, voffB); PG8_STAGE(PG8_SA(1, 0), cA + kstep, voffA); PG8_STAGE(PG8_SB(1, 1), cB + hstep + kstep, voffB);
        PG8_WAIT_V(6); PG8_BAR;
    } else {
        PG8_STAGE(PG8_SB(0, 0), cB, voffB); PG8_STAGE(PG8_SA(0, 0), cA, voffA); PG8_STAGE(PG8_SB(0, 1), cB + hstep, voffB); PG8_STAGE(PG8_SA(0, 1), cA + hstep, voffA);
        if (wr == 1) PG8_BAR;
        PG8_WAIT_V(4); PG8_BAR;
        PG8_STAGE(PG8_SB(1, 0), cB + kstep, voffB); PG8_STAGE(PG8_SA(1, 0), cA + kstep, voffA); PG8_STAGE(PG8_SB(1, 1), cB + hstep + kstep, voffB);
        PG8_WAIT_V(6); PG8_BAR;
    }
    for (;;) {
        const bool has_next = S.next(ui + 1, nxt);
        const char* nA = has_next ? (const char*)g.A + (size_t)nxt.pm * tstep : cA; const char* nB = has_next ? (const char*)g.Bt + (size_t)nxt.pn * tstep : cB;
        for (int t = 0; t < nt; t += 2) {
            const bool last = (t == nt - 2);
            const char* a1 = cA + (size_t)(t + 1) * kstep;
            const char* a2 = last ? nA : cA + (size_t)(t + 2) * kstep; const char* b2 = last ? nB : cB + (size_t)(t + 2) * kstep;
            const char* a3 = a2 + kstep; const char* b3 = b2 + kstep;
            if (last && has_next) S.a_ready(nxt);
            if constexpr (SP2) {
            PG8_LDB(B0, 0, 0); PG8_LDB(B1, 0, 1); PG8_SCHED; PG8_LDA(At, 0, 0); PG8_STAGE(PG8_SA(1, 1), a1 + hstep, voffA);
            PG8_WAIT_V(8); PG8_WAIT_L(0); PG8_BAR; PG8_MMA(0, 0, At, B0); PG8_MMA(0, 1, At, B1); PG8_BAR; PG8_SCHED;
            PG8_LDA(At, 0, 1); PG8_STAGE(PG8_SB(0, 0), b2, voffB); PG8_STAGE(PG8_SB(0, 1), b2 + hstep, voffB); PG8_STAGE(PG8_SA(0, 0), a2, voffA);
            PG8_WAIT_V(8); PG8_WAIT_L(0); PG8_BAR; PG8_MMA(1, 0, At, B0); PG8_MMA(1, 1, At, B1); PG8_BAR; PG8_SCHED;
            PG8_LDB(B0, 1, 0); PG8_LDB(B1, 1, 1); PG8_SCHED; PG8_LDA(At, 1, 0); PG8_STAGE(PG8_SA(0, 1), a2 + hstep, voffA);
            PG8_WAIT_V(8); PG8_WAIT_L(0); PG8_BAR; PG8_MMA(0, 0, At, B0); PG8_MMA(0, 1, At, B1); PG8_BAR; PG8_SCHED;
            PG8_LDA(At, 1, 1); PG8_STAGE(PG8_SB(1, 0), b3, voffB); PG8_STAGE(PG8_SB(1, 1), b3 + hstep, voffB); PG8_STAGE(PG8_SA(1, 0), a3, voffA);
            PG8_WAIT_V(8); PG8_WAIT_L(0); PG8_BAR; PG8_MMA(1, 0, At, B0); PG8_MMA(1, 1, At, B1); PG8_BAR; PG8_SCHED;
            } else {
            PG8_LDB(B0, 0, 0); PG8_SCHED; PG8_LDA(At, 0, 0); PG8_STAGE(PG8_SA(1, 1), a1 + hstep, voffA);
            PG8_WAIT_L(8); PG8_BAR; PG8_WAIT_L(0); PG8_MMA(0, 0, At, B0); PG8_BAR; PG8_SCHED;
            PG8_LDB(B1, 0, 1); PG8_STAGE(PG8_SB(0, 0), b2, voffB);
            PG8_BAR; PG8_WAIT_L(0); PG8_MMA(0, 1, At, B1); PG8_BAR;
            PG8_LDA(At, 0, 1); PG8_STAGE(PG8_SA(0, 0), a2, voffA);
            PG8_BAR; PG8_WAIT_L(0); PG8_MMA(1, 0, At, B0); PG8_BAR; PG8_SCHED;
            PG8_STAGE(PG8_SB(0, 1), b2 + hstep, voffB);
            PG8_WAIT_V(6); PG8_BAR; PG8_MMA(1, 1, At, B1); PG8_BAR;
            PG8_LDB(B0, 1, 0); PG8_SCHED; PG8_LDA(At, 1, 0); PG8_STAGE(PG8_SA(0, 1), a2 + hstep, voffA);
            PG8_WAIT_L(8); PG8_BAR; PG8_WAIT_L(0); PG8_MMA(0, 0, At, B0); PG8_BAR; PG8_SCHED;
            PG8_LDB(B1, 1, 1); PG8_STAGE(PG8_SB(1, 0), b3, voffB);
            PG8_BAR; PG8_WAIT_L(0); PG8_MMA(0, 1, At, B1); PG8_BAR;
            PG8_LDA(At, 1, 1); PG8_STAGE(PG8_SA(1, 0), a3, voffA);
            PG8_BAR; PG8_WAIT_L(0); PG8_MMA(1, 0, At, B0); PG8_BAR; PG8_SCHED;
            PG8_STAGE(PG8_SB(1, 1), b3 + hstep, voffB);
            PG8_WAIT_V(6); PG8_BAR; PG8_MMA(1, 1, At, B1); PG8_BAR;
            }
        }
        if constexpr (ALIGN_EPI) { if (wr == 0) PG8_BAR; }
        if constexpr (!Epi::AFTER_DRAIN) { E(acc, cur, wr, wc, fr, fq); S.done(cur); }
        if (!has_next) break;
#pragma unroll
        for (int a = 0; a < 2; ++a)
#pragma unroll
            for (int b = 0; b < 2; ++b)
#pragma unroll
                for (int m = 0; m < 4; ++m)
#pragma unroll
                    for (int n = 0; n < 2; ++n) acc[a][b][m][n] = (f32x4){0.f, 0.f, 0.f, 0.f};
        cur = nxt; cA = nA; cB = nB; ++ui;
        if constexpr (ALIGN_EPI) { if (wr == 1) PG8_BAR; }
    }
    PG8_WAIT_V(0);
    if constexpr (!ALIGN_EPI) { if (wr == 0) PG8_BAR; }
    PG8_BAR;
    if constexpr (Epi::AFTER_DRAIN) { E.fused(acc, cur, wr, wc, fr, fq, lds, wid, lane); S.done(cur); }
#undef PG8_SA
#undef PG8_SB
#undef PG8_STAGE
#undef PG8_LDA
#undef PG8_LDB
#undef PG8_MMA
#undef PG8_WAIT_V
#undef PG8_WAIT_L
#undef PG8_BAR
#undef PG8_SCHED
}
}

struct Args {
    const float* in[19]; float* out; unsigned char* ws; int ph_lo, ph_hi;
};
struct Frame {
    const float *x_prompt, *x_sample, *cache_k, *cache_v, *st_f, *st_b, *c, *c_ctx, *norm_gain, *w_mod, *b_mod, *w_in, *w_alpha, *b_alpha, *dlam, *gla_gain, *diff_gain, *w_out, *final_gain;
    float* out; unsigned char* ws;
    float *MOD, *H, *P, *OGF, *OGB, *OD, *MG;
    float *ROPE, *LR;
    unsigned short *WINT, *WOT, *HB, *QG, *KG, *VG, *DQ, *DKP, *DVP, *DKS, *DVS, *SG, *MGB, *VGT;
    unsigned char* GSC;
    int tid, lane, wave, G, bid;
};
__device__ __forceinline__ float wave_sum(float v) {
#pragma unroll
    for (int o = 32; o > 0; o >>= 1) v += __shfl_xor(v, o);
    return v;
}
__device__ __forceinline__ float wave_max(float v) {
#pragma unroll
    for (int o = 32; o > 0; o >>= 1) v = fmaxf(v, __shfl_xor(v, o));
    return v;
}
__device__ __forceinline__ float silu_f(float x) { return x / (1.0f + expf(-x)); }
__device__ __forceinline__ const float* xrow(const Frame& F, int r) { return r < NPR ? F.x_prompt + (size_t)r * D : F.x_sample + (size_t)(r - NPR) * D; }
__device__ __forceinline__ int variant_of(int r) { return r < NPR ? 0 : 1 + (r - NPR) / 1024; }
__device__ __forceinline__ float lam_value(const Frame& F) {
    float a = 0.f, b = 0.f;
    for (int i = 0; i < 64; ++i) { a += F.dlam[i] * F.dlam[64 + i]; b += F.dlam[128 + i] * F.dlam[192 + i]; }
    return expf(a) - expf(b) + 0.2f;
}

__device__ void ph_mod(const Frame& F) {
    for (int e = F.bid * NTHR + F.tid; e < 3072; e += F.G * NTHR) {
        float a0 = 0.f, a1 = 0.f, a2 = 0.f;
        for (int d = 0; d < D; ++d) {
            const float w = F.w_mod[(size_t)d * 3072 + e];
            a0 += silu_f(F.c_ctx[d]) * w; a1 += silu_f(F.c[d]) * w; a2 += silu_f(F.c[D + d]) * w;
        }
        const float bb = F.b_mod[e];
        F.MOD[e] = a0 + bb; F.MOD[3072 + e] = a1 + bb; F.MOD[6144 + e] = a2 + bb;
    }
}
__device__ void ph_h(const Frame& F) {
    for (int r = F.bid * 8 + F.wave; r < NT; r += F.G * 8) {
        const float* x = xrow(F, r); const float* m = F.MOD + variant_of(r) * 3072;
        float4 v[4]; float ss = 0.f;
#pragma unroll
        for (int i = 0; i < 4; ++i) { v[i] = *(const float4*)(x + i * 256 + F.lane * 4); ss += v[i].x * v[i].x + v[i].y * v[i].y + v[i].z * v[i].z + v[i].w * v[i].w; }
        ss = wave_sum(ss);
        const float rstd = 1.0f / sqrtf(ss * (1.0f / 1024.0f) + 1e-6f);
#pragma unroll
        for (int i = 0; i < 4; ++i) {
            const int k = i * 256 + F.lane * 4;
            const float4 g = *(const float4*)(F.norm_gain + k), sh = *(const float4*)(m + k), sc = *(const float4*)(m + 1024 + k);
            float4 o;
            o.x = v[i].x * rstd * g.x * (1.0f + sc.x) + sh.x; o.y = v[i].y * rstd * g.y * (1.0f + sc.y) + sh.y;
            o.z = v[i].z * rstd * g.z * (1.0f + sc.z) + sh.z; o.w = v[i].w * rstd * g.w * (1.0f + sc.w) + sh.w;
            *(float4*)(F.H + (size_t)r * D + k) = o;
        }
    }
}
template <class Epi>
__device__ void gemm_naive(const Frame& F, LAS float* lds, const float* A, int lda, const float* B, int ldb, int M, int N, int K, const Epi& E) {
    LAS float* As = lds;
    LAS float* Bs = lds + 16 * 132;
    const int ntn = (N + 63) / 64, ntm = M / 128, nt = ntn * ntm;
    const int tid = F.tid, ty = tid >> 4, tx = tid & 15;
    for (int t = F.bid; t < nt; t += F.G) {
        const int tm = t / ntn, tn = t % ntn, row0 = tm * 128, col0 = tn * 64;
        float acc[4][4];
#pragma unroll
        for (int i = 0; i < 4; ++i)
#pragma unroll
            for (int j = 0; j < 4; ++j) acc[i][j] = 0.f;
        for (int k0 = 0; k0 < K; k0 += 16) {
            { const int r = tid >> 2, kq = (tid & 3) * 4; const float4 a = *(const float4*)(A + (size_t)(row0 + r) * lda + k0 + kq);
              As[(kq + 0) * 132 + r] = a.x; As[(kq + 1) * 132 + r] = a.y; As[(kq + 2) * 132 + r] = a.z; As[(kq + 3) * 132 + r] = a.w; }
            { const int k = tid >> 5, c = (tid & 31) * 2; float2 b = make_float2(0.f, 0.f); if (col0 + c < N) b = *(const float2*)(B + (size_t)(k0 + k) * ldb + col0 + c);
              Bs[k * 64 + c] = b.x; Bs[k * 64 + c + 1] = b.y; }
            __syncthreads();
#pragma unroll
            for (int kk = 0; kk < 16; ++kk) {
                float a[4], b[4];
#pragma unroll
                for (int i = 0; i < 4; ++i) { a[i] = As[kk * 132 + ty * 4 + i]; b[i] = Bs[kk * 64 + tx * 4 + i]; }
#pragma unroll
                for (int i = 0; i < 4; ++i)
#pragma unroll
                    for (int j = 0; j < 4; ++j) acc[i][j] += a[i] * b[j];
            }
            __syncthreads();
        }
#pragma unroll
        for (int i = 0; i < 4; ++i)
#pragma unroll
            for (int j = 0; j < 4; ++j) { const int r = row0 + ty * 4 + i, c = col0 + tx * 4 + j; if (c < N) E(r, c, acc[i][j]); }
    }
}
struct EpiIn { float* P; float* out;
    __device__ __forceinline__ void operator()(int r, int c, float v) const {
        P[(size_t)r * PW + c] = v;
        if (r < NPR) { if (c >= C_DK && c < C_DV) out[O_NK + (size_t)r * 512 + (c - C_DK)] = v; else if (c >= C_DV && c < C_GATE) out[O_NV + (size_t)r * 512 + (c - C_DV)] = v; }
    } };
struct EpiOut { const Frame* F;
    __device__ __forceinline__ void operator()(int r, int c, float v) const {
        const float gt = F->MOD[variant_of(r) * 3072 + 2048 + c];
        F->out[(size_t)r * D + c] = xrow(*F, r)[c] + gt * v;
    } };
__device__ void ph_rope(const Frame& F) {
    const long total = (long)NSR * 512;
    for (long idx = (long)F.bid * NTHR + F.tid; idx < total; idx += (long)F.G * NTHR) {
        const int p = (int)(idx & 31), vec = (int)((idx >> 5) & 7), which = (int)((idx >> 8) & 1), rs = (int)(idx >> 9);
        const int t = rs & 1023, gr = t >> 6, gc = t & 63;
        const int i = p & 15; const int pos = p < 16 ? gr : gc; const int d1 = (p < 16 ? 0 : 32) + i, d2 = d1 + 16;
        const float inv = powf(10000.0f, -(float)i / 16.0f);
        const float ang = (float)pos * inv, cs = cosf(ang), sn = sinf(ang);
        float* base = F.P + (size_t)(NPR + rs) * PW + (which ? C_DK : C_DQ) + vec * 64;
        const float v1 = base[d1], v2 = base[d2];
        base[d1] = v1 * cs - v2 * sn; base[d2] = v1 * sn + v2 * cs;
    }
}
__device__ __forceinline__ float log_sigmoid_f(float z) { return fminf(z, 0.f) - log1pf(expf(-fabsf(z))); }
__device__ void ph_gla(const Frame& F, LAS float* lds) {
    LAS float* al = lds;
    LAS float* qs = al + 4096;
    LAS float* ks = qs + 4096;
    LAS float* vs = ks + 4096;
    LAS float* po = vs + 8192;
    const int tid = F.tid, j = tid & 127, kq = tid >> 7;
    for (int item = F.bid; item < 144; item += F.G) {
        int grp, b, h, dir;
        if (item < 128) { grp = 0; b = item >> 3; h = (item >> 1) & 3; dir = item & 1; } else { const int it = item - 128; grp = 1; b = it >> 3; h = (it >> 1) & 3; dir = it & 1; }
        const int R0 = grp == 0 ? b * 256 : NPR + b * 1024, n = grp == 0 ? 256 : 1024;
        float S[16];
        if (grp == 0) {
#pragma unroll
            for (int i = 0; i < 16; ++i) S[i] = 0.f;
        } else {
            const float* st = (dir == 0 ? F.st_f : F.st_b) + (size_t)(b * 4 + h) * 64 * 128;
#pragma unroll
            for (int i = 0; i < 16; ++i) S[i] = st[(kq * 16 + i) * 128 + j];
        }
        float* OG = dir == 0 ? F.OGF : F.OGB;
        for (int c0 = 0; c0 < n; c0 += 64) {
            __syncthreads();
            for (int e = tid; e < 4096; e += NTHR) {
                const int s = e >> 6, k = e & 63; const int t = dir == 0 ? c0 + s : n - 1 - (c0 + s); const float* prow = F.P + (size_t)(R0 + t) * PW;
                float z = F.b_alpha[dir * 256 + h * 64 + k];
                for (int r = 0; r < 16; ++r) z += prow[(dir == 0 ? C_LRF : C_LRB) + r] * F.w_alpha[(size_t)(dir * 16 + r) * 256 + h * 64 + k];
                al[e] = expf(log_sigmoid_f(z) * (1.0f / 16.0f));
                qs[e] = prow[C_GQ + h * 64 + k] * 0.125f;
                ks[e] = prow[C_GK + h * 64 + k];
            }
            for (int e = tid; e < 8192; e += NTHR) {
                const int s = e >> 7, jj = e & 127; const int t = dir == 0 ? c0 + s : n - 1 - (c0 + s);
                vs[e] = F.P[(size_t)(R0 + t) * PW + C_GV + h * 128 + jj];
            }
            __syncthreads();
            for (int s = 0; s < 64; ++s) {
                const float v = vs[s * 128 + j]; float o = 0.f;
#pragma unroll
                for (int i = 0; i < 16; ++i) { const int k = kq * 16 + i; S[i] = al[s * 64 + k] * S[i] + ks[s * 64 + k] * v; o += qs[s * 64 + k] * S[i]; }
                po[((s & 1) * 4 + kq) * 128 + j] = o;
                __syncthreads();
                if (kq == 0) {
                    const int t = dir == 0 ? c0 + s : n - 1 - (c0 + s);
                    const int pb = (s & 1) * 4;
                    OG[(size_t)(R0 + t) * 512 + h * 128 + j] = po[(pb + 0) * 128 + j] + po[(pb + 1) * 128 + j] + po[(pb + 2) * 128 + j] + po[(pb + 3) * 128 + j];
                }
            }
        }
        if (grp == 0) {
            float* so = F.out + (dir == 0 ? O_SF : O_SB) + (size_t)(b * 4 + h) * 64 * 128;
#pragma unroll
            for (int i = 0; i < 16; ++i) so[(kq * 16 + i) * 128 + j] = S[i];
        }
    }
}
__device__ void ph_diff(const Frame& F, LAS float* lds) {
    LAS float* wl = lds + F.wave * 3328;
    LAS float* qb = wl; LAS float* s1 = wl + 128; LAS float* s2 = s1 + 1536;
    const float lam = lam_value(F);
    const int lane = F.lane;
    for (int item = F.bid * 8 + F.wave; item < NT * 4; item += F.G * 8) {
        const int r = item >> 2, h = item & 3;
        int R0, nc, nk, b;
        if (r < NPR) { b = r >> 8; R0 = b * 256; nc = 0; nk = 256; } else { b = (r - NPR) >> 10; R0 = NPR + b * 1024; nc = 512; nk = 1536; }
        const float* qp = F.P + (size_t)r * PW + C_DQ + h * 128;
        qb[lane] = qp[lane]; qb[64 + lane] = qp[64 + lane];
        __builtin_amdgcn_wave_barrier();
        float m1 = -3.0e38f, m2 = -3.0e38f;
        for (int jk = lane; jk < nk; jk += 64) {
            const float* kp = jk < nc ? F.cache_k + ((size_t)(b * 512 + jk) * 4 + h) * 128 : F.P + (size_t)(R0 + jk - nc) * PW + C_DK + h * 128;
            float a1 = 0.f, a2 = 0.f;
            for (int d = 0; d < 64; d += 4) {
                const float4 k1 = *(const float4*)(kp + d), k2 = *(const float4*)(kp + 64 + d);
                a1 += qb[d] * k1.x + qb[d + 1] * k1.y + qb[d + 2] * k1.z + qb[d + 3] * k1.w;
                a2 += qb[64 + d] * k2.x + qb[64 + d + 1] * k2.y + qb[64 + d + 2] * k2.z + qb[64 + d + 3] * k2.w;
            }
            a1 *= 0.125f; a2 *= 0.125f; s1[jk] = a1; s2[jk] = a2; m1 = fmaxf(m1, a1); m2 = fmaxf(m2, a2);
        }
        m1 = wave_max(m1); m2 = wave_max(m2);
        float l1 = 0.f, l2 = 0.f;
        for (int jk = lane; jk < nk; jk += 64) { const float e1 = expf(s1[jk] - m1), e2 = expf(s2[jk] - m2); s1[jk] = e1; s2[jk] = e2; l1 += e1; l2 += e2; }
        l1 = wave_sum(l1); l2 = wave_sum(l2);
        const float i1 = 1.0f / l1, i2 = lam / l2;
        for (int jk = lane; jk < nk; jk += 64) s1[jk] = s1[jk] * i1 - s2[jk] * i2;
        __builtin_amdgcn_wave_barrier();
        float2 acc = make_float2(0.f, 0.f);
        for (int jk = 0; jk < nk; ++jk) {
            const float* vp = jk < nc ? F.cache_v + ((size_t)(b * 512 + jk) * 4 + h) * 128 : F.P + (size_t)(R0 + jk - nc) * PW + C_DV + h * 128;
            const float a = s1[jk]; const float2 v = *(const float2*)(vp + lane * 2);
            acc.x += a * v.x; acc.y += a * v.y;
        }
        *(float2*)(F.OD + (size_t)r * 512 + h * 128 + lane * 2) = acc;
        __builtin_amdgcn_wave_barrier();
    }
}

typedef unsigned short bf16_t;
typedef float f32x4 __attribute__((ext_vector_type(4)));
__device__ __forceinline__ unsigned f2bf(float f) { unsigned u = __builtin_bit_cast(unsigned, f); return (u + 0x7fffu + ((u >> 16) & 1u)) >> 16; }
__device__ __forceinline__ unsigned pk2(float lo, float hi) { return f2bf(lo) | (f2bf(hi) << 16); }
__device__ __forceinline__ void st_bf16x4(bf16_t* p, f32x4 v) { uint2 w; w.x = pg8::cvt_pk_bf16(v[0], v[1]); w.y = pg8::cvt_pk_bf16(v[2], v[3]); *(uint2*)p = w; }
__device__ __forceinline__ int orig_col(int n) { return n < 1024 ? n : (n < 3584 ? n + 32 : (n < 3616 ? n - 3584 + 1024 : -1)); }

__device__ __forceinline__ void ph_prep(const Frame& F, LAS unsigned char* lds) {
    const int tid = F.tid, lane = F.lane, wave = F.wave;
    {
        LAS float* red = (LAS float*)lds;
        for (int item = F.bid; item < 256; item += F.G) {
            const int cg = item & 7, kg = item >> 3, k0 = kg * 32 + wave * 4;
            float acc[3][3][2];
#pragma unroll
            for (int v = 0; v < 3; ++v)
#pragma unroll
                for (int i = 0; i < 3; ++i) { acc[v][i][0] = 0.f; acc[v][i][1] = 0.f; }
#pragma unroll
            for (int kk = 0; kk < 4; ++kk) {
                const int k = k0 + kk;
                const float s0 = silu_f(F.c_ctx[k]), s1 = silu_f(F.c[k]), s2 = silu_f(F.c[D + k]);
#pragma unroll
                for (int i = 0; i < 3; ++i) {
                    const float2 w = *(const float2*)(F.w_mod + (size_t)k * 3072 + cg * 384 + i * 128 + lane * 2);
                    acc[0][i][0] += s0 * w.x; acc[0][i][1] += s0 * w.y; acc[1][i][0] += s1 * w.x; acc[1][i][1] += s1 * w.y; acc[2][i][0] += s2 * w.x; acc[2][i][1] += s2 * w.y;
                }
            }
#pragma unroll
            for (int v = 0; v < 3; ++v)
#pragma unroll
                for (int i = 0; i < 3; ++i) { red[(wave * 3 + v) * 384 + i * 128 + lane * 2] = acc[v][i][0]; red[(wave * 3 + v) * 384 + i * 128 + lane * 2 + 1] = acc[v][i][1]; }
            __syncthreads();
            for (int e = tid; e < 1152; e += NTHR) {
                const int v = e / 384, col = e - v * 384; float s = 0.f;
#pragma unroll
                for (int w = 0; w < 8; ++w) s += red[(w * 3 + v) * 384 + col];
                if (kg == 0) s += F.b_mod[cg * 384 + col];
                atomicAdd(&F.MOD[v * 3072 + cg * 384 + col], s);
            }
            __syncthreads();
        }
    }
    {
        LAS unsigned short* T = (LAS unsigned short*)lds;
        for (int t = F.bid; t < 1216; t += F.G) {
            const bool isin = t < 960; const int tt = isin ? t : t - 960; const int n0 = (tt >> 4) * 64, k0 = (tt & 15) * 64;
            const float* W = isin ? F.w_in : F.w_out; const int ldw = isin ? PW : D;
            {
                const int k = tid >> 3, n8 = (tid & 7) * 8; const int oc = isin ? orig_col(n0 + n8) : n0 + n8;
                float4 a = make_float4(0.f, 0.f, 0.f, 0.f), b = a;
                if (oc >= 0) { const float* p = W + (size_t)(k0 + k) * ldw + oc; a = *(const float4*)p; b = *(const float4*)(p + 4); }
                T[(n8 + 0) * 66 + k] = (unsigned short)f2bf(a.x); T[(n8 + 1) * 66 + k] = (unsigned short)f2bf(a.y); T[(n8 + 2) * 66 + k] = (unsigned short)f2bf(a.z); T[(n8 + 3) * 66 + k] = (unsigned short)f2bf(a.w);
                T[(n8 + 4) * 66 + k] = (unsigned short)f2bf(b.x); T[(n8 + 5) * 66 + k] = (unsigned short)f2bf(b.y); T[(n8 + 6) * 66 + k] = (unsigned short)f2bf(b.z); T[(n8 + 7) * 66 + k] = (unsigned short)f2bf(b.w);
            }
            __syncthreads();
            {
                const int n = tid >> 3, k8 = (tid & 7) * 8; const LAS unsigned* rp = (const LAS unsigned*)(T + n * 66 + k8);
                uint4 w; w.x = rp[0]; w.y = rp[1]; w.z = rp[2]; w.w = rp[3];
                bf16_t* dst = (isin ? F.WINT : F.WOT) + (size_t)(n0 + n) * D + k0 + k8;
                *(uint4*)dst = w;
            }
            __syncthreads();
        }
    }
    {
        for (int e8 = F.bid * NTHR + tid; e8 < 2 * 65536; e8 += F.G * NTHR) {
            const bool isv = e8 >= 65536; const int g = isv ? e8 - 65536 : e8; const int e = g * 8;
            const int b = e >> 18, rem = e & 262143, j = rem >> 9, c = rem & 511;
            const float* src = (isv ? F.cache_v : F.cache_k) + e;
            const float4 a = *(const float4*)src, bb = *(const float4*)(src + 4);
            uint4 w; w.x = pk2(a.x, a.y); w.y = pk2(a.z, a.w); w.z = pk2(bb.x, bb.y); w.w = pk2(bb.z, bb.w);
            *(uint4*)((isv ? F.DVS : F.DKS) + ((size_t)(b * 1536 + j) * 512 + c)) = w;
        }
    }
    {
        for (int idx = F.bid * NTHR + tid; idx < 1024; idx += F.G * NTHR) {
            const int pos = idx >> 4, i = idx & 15;
            const float ang = (float)pos * powf(10000.0f, -(float)i / 16.0f);
            F.ROPE[idx] = cosf(ang); F.ROPE[1024 + idx] = sinf(ang);
        }
    }
}
__device__ __forceinline__ void ph_hb(const Frame& F) {
    for (int r = F.bid * 8 + F.wave; r < NT; r += F.G * 8) {
        const float* x = xrow(F, r); const float* m = F.MOD + variant_of(r) * 3072;
        float4 v[4]; float ss = 0.f;
#pragma unroll
        for (int i = 0; i < 4; ++i) { v[i] = *(const float4*)(x + i * 256 + F.lane * 4); ss += v[i].x * v[i].x + v[i].y * v[i].y + v[i].z * v[i].z + v[i].w * v[i].w; }
        ss = wave_sum(ss);
        const float rstd = 1.0f / sqrtf(ss * (1.0f / 1024.0f) + 1e-6f);
#pragma unroll
        for (int i = 0; i < 4; ++i) {
            const int k = i * 256 + F.lane * 4;
            const float4 g = *(const float4*)(F.norm_gain + k), sh = *(const float4*)(m + k), sc = *(const float4*)(m + 1024 + k);
            uint2 w;
            w.x = pk2(v[i].x * rstd * g.x * (1.0f + sc.x) + sh.x, v[i].y * rstd * g.y * (1.0f + sc.y) + sh.y);
            w.y = pk2(v[i].z * rstd * g.z * (1.0f + sc.z) + sh.z, v[i].w * rstd * g.w * (1.0f + sc.w) + sh.w);
            *(uint2*)(F.HB + (size_t)r * D + k) = w;
        }
    }
}
constexpr float QSCALE_DIFF = 0.125f * 1.4426950408889634f;
struct EpiInFast {
    static constexpr bool PERM = false, AFTER_DRAIN = false;
    bf16_t *QG, *KG, *VGT, *DQ, *DKP, *DVP, *DKS, *DVS, *SG; float* LR; float* out; const float* ROPE; float* P;
    __device__ __forceinline__ void operator()(const f32x4 (&acc)[2][2][4][2], const pg8::Unit& u, int wr, int wc, int fr, int fq) const {
        const int pn = u.pn; const bool samp = u.pm >= 16;
#pragma unroll
        for (int ai = 0; ai < 2; ++ai)
#pragma unroll
            for (int m = 0; m < 4; ++m) {
                const int row = u.pm * 256 + ai * 128 + wr * 64 + m * 16 + fr;
                const int ts = (row - NPR) & 1023, bs = (row - NPR) >> 10;
#pragma unroll
                for (int bj = 0; bj < 2; ++bj) {
                    f32x4 v0 = acc[ai][bj][m][0], v1 = acc[ai][bj][m][1];
                    const int cl = bj * 128 + wc * 32 + fq * 4;
                    if (pn == 0) { st_bf16x4(QG + (size_t)row * 256 + cl, v0 * 0.125f); st_bf16x4(QG + (size_t)row * 256 + cl + 16, v1 * 0.125f); }
                    else if (pn == 1) { st_bf16x4(KG + (size_t)row * 256 + cl, v0); st_bf16x4(KG + (size_t)row * 256 + cl + 16, v1); }
                    else if (pn < 4) {
                        bf16_t* d = VGT + (size_t)((pn - 2) * 256 + cl) * NT + row;
#pragma unroll
                        for (int e = 0; e < 4; ++e) { d[(size_t)e * NT] = (bf16_t)f2bf(v0[e]); d[(size_t)(16 + e) * NT] = (bf16_t)f2bf(v1[e]); }
                    }
                    else if (pn < 8) {
                        const bool isk = pn >= 6; const int c512 = (pn - (isk ? 6 : 4)) * 256 + cl;
                        if (samp) {
                            const int pos = (wc & 1) ? (ts & 63) : (ts >> 6);
                            const f32x4 cs = *(const f32x4*)(ROPE + pos * 16 + fq * 4), sn = *(const f32x4*)(ROPE + 1024 + pos * 16 + fq * 4);
                            const f32x4 r0 = v0 * cs - v1 * sn, r1 = v0 * sn + v1 * cs; v0 = r0; v1 = r1;
                        }
                        if (!isk) { bf16_t* d = DQ + (size_t)row * 512 + c512; st_bf16x4(d, v0 * QSCALE_DIFF); st_bf16x4(d + 16, v1 * QSCALE_DIFF); }
                        else if (!samp) { float* o = out + O_NK + (size_t)row * 512 + c512; *(f32x4*)o = v0; *(f32x4*)(o + 16) = v1; bf16_t* d = DKP + (size_t)row * 512 + c512; st_bf16x4(d, v0); st_bf16x4(d + 16, v1); }
                        else { bf16_t* d = DKS + ((size_t)(bs * 1536 + 512 + ts)) * 512 + c512; st_bf16x4(d, v0); st_bf16x4(d + 16, v1); }
                    }
                    else if (pn < 10) {
                        const int c512 = (pn - 8) * 256 + cl;
                        if (!samp) { float* o = out + O_NV + (size_t)row * 512 + c512; *(f32x4*)o = v0; *(f32x4*)(o + 16) = v1; bf16_t* d = DVP + (size_t)row * 512 + c512; st_bf16x4(d, v0); st_bf16x4(d + 16, v1); }
                        else { bf16_t* d = DVS + ((size_t)(bs * 1536 + 512 + ts)) * 512 + c512; st_bf16x4(d, v0); st_bf16x4(d + 16, v1); }
                    }
                    else if (pn < 14) {
                        bf16_t* d = SG + (size_t)row * 1024 + (pn - 10) * 256 + cl;
                        f32x4 s0, s1;
#pragma unroll
                        for (int j = 0; j < 4; ++j) { s0[j] = v0[j] / (1.0f + __expf(-v0[j])); s1[j] = v1[j] / (1.0f + __expf(-v1[j])); }
                        st_bf16x4(d, s0); st_bf16x4(d + 16, s1);
                    }
                    else { if (bj == 0 && wc == 0) { float* o = LR + (size_t)row * 32 + fq * 4; *(f32x4*)o = v0; *(f32x4*)(o + 16) = v1; } }
                    if (P) {
                        const int n0 = pn * 256 + cl; const int oc = orig_col(n0);
                        if (oc >= 0) { *(f32x4*)(P + (size_t)row * PW + oc) = v0; *(f32x4*)(P + (size_t)row * PW + oc + 16) = v1; }
                    }
                }
            }
    }
};


struct EpiOutFast {
    static constexpr bool PERM = false, AFTER_DRAIN = false;
    const float* x_prompt; const float* x_sample; const float* MOD; float* out;
    __device__ __forceinline__ void operator()(const f32x4 (&acc)[2][2][4][2], const pg8::Unit& u, int wr, int wc, int fr, int fq) const {
        const float* gt = MOD + (u.pm < 16 ? 0 : (u.pm < 20 ? 1 : 2)) * 3072 + 2048;
#pragma unroll
        for (int ai = 0; ai < 2; ++ai)
#pragma unroll
            for (int m = 0; m < 4; ++m) {
                const int row = u.pm * 256 + ai * 128 + wr * 64 + m * 16 + fr;
                const float* xr = row < NPR ? x_prompt + (size_t)row * D : x_sample + (size_t)(row - NPR) * D;
#pragma unroll
                for (int bj = 0; bj < 2; ++bj)
#pragma unroll
                    for (int n = 0; n < 2; ++n) {
                        const int col = u.pn * 256 + bj * 128 + wc * 32 + n * 16 + fq * 4;
                        const f32x4 xv = *(const f32x4*)(xr + col), g4 = *(const f32x4*)(gt + col);
                        *(f32x4*)(out + (size_t)row * D + col) = xv + g4 * acc[ai][bj][m][n];
                    }
            }
    }
};


typedef short bf16x8 __attribute__((ext_vector_type(8)));
typedef short s16x4 __attribute__((ext_vector_type(4)));
typedef __bf16 bf16x8_t __attribute__((ext_vector_type(8)));
typedef float f32x8 __attribute__((ext_vector_type(8)));
typedef float f32x16 __attribute__((ext_vector_type(16)));
typedef unsigned u32x4 __attribute__((ext_vector_type(4)));
#define MFMA32(a, b, c) __builtin_amdgcn_mfma_f32_32x32x16_bf16((a), (b), (c), 0, 0, 0)
__device__ __forceinline__ bf16x8 pack8(f32x8 v) { return __builtin_bit_cast(bf16x8, __builtin_convertvector(v, bf16x8_t)); }
__device__ __forceinline__ float bf2f(unsigned short u) { return __builtin_bit_cast(float, (unsigned)u << 16); }
__device__ __forceinline__ bf16x8 tr8(const LAS unsigned char* p0, const LAS unsigned char* p1) {
    const s16x4 lo = __builtin_amdgcn_ds_read_tr16_b64_v4i16((LAS s16x4*)p0), hi = __builtin_amdgcn_ds_read_tr16_b64_v4i16((LAS s16x4*)p1);
    return __builtin_shufflevector(lo, hi, 0, 1, 2, 3, 4, 5, 6, 7);
}
constexpr int AT_KROW = 272, AT_VROW = 320, AT_KBYTES = 64 * AT_KROW, AT_STAGE = AT_KBYTES + 64 * AT_VROW;
constexpr int AT_EXROW = 129;

__device__ __forceinline__ void attn_item(const Frame& F, LAS unsigned char* lds, int grp, int b, int h, int qblk, float lam) {
    int tid = F.tid; asm volatile("" : "+v"(tid));
    const int lane = tid & 63, wave = __builtin_amdgcn_readfirstlane(tid >> 6), rg = wave & 3, map = wave >> 2, r = lane & 31, hh = lane >> 5;
    const int R0 = grp == 0 ? b * 256 : NPR + b * 1024, nk = grp == 0 ? 256 : 1536;
    const size_t kvoff = (size_t)(b * nk) * 512 + h * 128;
    const bf16_t* Kb = (const bf16_t*)(F.ws + (grp == 0 ? WS_DKP : WS_DKS)) + kvoff;
    const bf16_t* Vb = (const bf16_t*)(F.ws + (grp == 0 ? WS_DVP : WS_DVS)) + kvoff;
    const int qrow = R0 + qblk * 128 + rg * 32 + r;
    bf16x8 qf[4];
#pragma unroll
    for (int ks = 0; ks < 4; ++ks) qf[ks] = *(const bf16x8*)(F.DQ + (size_t)qrow * 512 + h * 128 + map * 64 + ks * 16 + hh * 8);
    f32x16 O[4];
#pragma unroll
    for (int jt = 0; jt < 4; ++jt)
#pragma unroll
        for (int i = 0; i < 16; ++i) O[jt][i] = 0.f;
    float m_run = -1.0e30f, l_run = 0.f;
    const int nt = nk >> 6;
    const int srow0 = tid >> 4, sch = tid & 15;
    u32x4 stg[4];
#define AT_LOAD(t) do { _Pragma("unroll") for (int i = 0; i < 2; ++i) { \
        stg[i]     = *(const u32x4*)(Kb + (size_t)((t) * 64 + srow0 + 32 * i) * 512 + sch * 8); \
        stg[2 + i] = *(const u32x4*)(Vb + (size_t)((t) * 64 + srow0 + 32 * i) * 512 + sch * 8); } } while (0)
#define AT_WRITE(buf) do { _Pragma("unroll") for (int i = 0; i < 2; ++i) { \
        *(LAS u32x4*)(lds + (buf) * AT_STAGE + (srow0 + 32 * i) * AT_KROW + sch * 16) = stg[i]; \
        *(LAS u32x4*)(lds + (buf) * AT_STAGE + AT_KBYTES + (srow0 + 32 * i) * AT_VROW + sch * 16) = stg[2 + i]; } } while (0)
    const int koff = r * AT_KROW + map * 128 + hh * 16;
    const int voff = AT_KBYTES + (4 * hh + ((lane & 15) >> 2)) * AT_VROW + (16 * ((lane >> 4) & 1) + 4 * (lane & 3)) * 2;
    AT_LOAD(0); AT_WRITE(0);
    __syncthreads();
    for (int t = 0; t < nt; ++t) {
        const int buf = t & 1;
        if (t + 1 < nt) AT_LOAD(t + 1);
        const LAS unsigned char* sb = lds + buf * AT_STAGE;
        f32x16 S[2];
#pragma unroll
        for (int sub = 0; sub < 2; ++sub) {
#pragma unroll
            for (int i = 0; i < 16; ++i) S[sub][i] = 0.f;
#pragma unroll
            for (int ks = 0; ks < 4; ++ks) {
                const bf16x8 kf = *(const LAS bf16x8*)(sb + koff + sub * 32 * AT_KROW + ks * 32);
                S[sub] = MFMA32(kf, qf[ks], S[sub]);
            }
        }
        float mx = S[0][0];
#pragma unroll
        for (int i = 1; i < 16; ++i) mx = fmaxf(mx, S[0][i]);
#pragma unroll
        for (int i = 0; i < 16; ++i) mx = fmaxf(mx, S[1][i]);
        mx = fmaxf(mx, __shfl_xor(mx, 32));
        const float m_new = fmaxf(m_run, mx), alpha = __builtin_amdgcn_exp2f(m_run - m_new);
        m_run = m_new; l_run *= alpha;
#pragma unroll
        for (int jt = 0; jt < 4; ++jt) O[jt] = O[jt] * alpha;
        bf16x8 pb[2][2];
#pragma unroll
        for (int sub = 0; sub < 2; ++sub) {
            f32x8 p0, p1;
#pragma unroll
            for (int i = 0; i < 8; ++i) { p0[i] = __builtin_amdgcn_exp2f(S[sub][i] - m_new); p1[i] = __builtin_amdgcn_exp2f(S[sub][8 + i] - m_new); l_run += p0[i] + p1[i]; }
            pb[sub][0] = pack8(p0); pb[sub][1] = pack8(p1);
        }
#pragma unroll
        for (int sub = 0; sub < 2; ++sub)
#pragma unroll
            for (int s = 0; s < 2; ++s)
#pragma unroll
                for (int jt = 0; jt < 4; ++jt) {
                    const LAS unsigned char* vp = sb + voff + (32 * sub + 16 * s) * AT_VROW + jt * 64;
                    const bf16x8 vf = tr8(vp, vp + 8 * AT_VROW);
                    O[jt] = MFMA32(vf, pb[sub][s], O[jt]);
                }
        if (t + 1 < nt) AT_WRITE(buf ^ 1);
        __syncthreads();
    }
#undef AT_LOAD
#undef AT_WRITE
    const float l_tot = l_run + __shfl_xor(l_run, 32), inv = 1.0f / l_tot;
    LAS float* EX = (LAS float*)lds;
    {
        LAS float* ex = EX + (map * 128 + rg * 32 + r) * AT_EXROW;
#pragma unroll
        for (int jt = 0; jt < 4; ++jt)
#pragma unroll
            for (int i = 0; i < 16; ++i) ex[32 * jt + (i & 3) + 8 * (i >> 2) + 4 * hh] = O[jt][i] * inv;
    }
    __syncthreads();
    {
        const int ql = tid >> 2, part = tid & 3; const int row = R0 + qblk * 128 + ql;
        const LAS float* e0 = EX + ql * AT_EXROW + part * 32; const LAS float* e1 = e0 + 128 * AT_EXROW;
        float o[32]; float ss = 0.f;
#pragma unroll
        for (int j = 0; j < 32; ++j) { o[j] = e0[j] - lam * e1[j]; ss += o[j] * o[j]; }
        ss += __shfl_xor(ss, 1); ss += __shfl_xor(ss, 2);
        const float rstd = 0.8f / sqrtf(ss * (1.0f / 128.0f) + 1e-6f);
        const bf16_t* sg = F.SG + (size_t)row * 1024 + 512 + h * 128 + part * 32;
        bf16_t* dst = F.MGB + (size_t)row * 1024 + 512 + h * 128 + part * 32;
        const float* gain = F.diff_gain + part * 32;
#pragma unroll
        for (int c = 0; c < 4; ++c) {
            const uint4 gw = *(const uint4*)(sg + c * 8); const unsigned gws[4] = {gw.x, gw.y, gw.z, gw.w};
            unsigned w[4];
#pragma unroll
            for (int e = 0; e < 4; ++e) {
                const int j = c * 8 + e * 2;
                const float a0 = o[j] * rstd * gain[j] * bf2f((unsigned short)(gws[e] & 0xffffu)), a1 = o[j + 1] * rstd * gain[j + 1] * bf2f((unsigned short)(gws[e] >> 16));
                w[e] = pk2(a0, a1);
            }
            *(uint4*)(dst + c * 8) = make_uint4(w[0], w[1], w[2], w[3]);
        }
    }
    __syncthreads();
}

constexpr int GC_DS = 0, GC_SC = 32768, GC_BT = 49152, GC_QT = 65536, GC_KT = 73728, GC_BL = 81920, GC_DIR = 83968;
constexpr int GC_OF = 2 * GC_DIR, GC_BYTES = GC_OF + 32768;
constexpr int GL_LROW = 80, GL_LWAVE = 64 * GL_LROW;
constexpr float LOG2E = 1.4426950408889634f;
__device__ __forceinline__ int crow(int i, int hh) { return (i & 3) + 8 * (i >> 2) + 4 * hh; }
__device__ __forceinline__ f32x16 zero16() { f32x16 z; _Pragma("unroll") for (int i = 0; i < 16; ++i) z[i] = 0.f; return z; }
__device__ __forceinline__ void split8(const float (&x)[8], bf16x8& hi, bf16x8& lo) {
    f32x8 v, w;
#pragma unroll
    for (int i = 0; i < 8; ++i) v[i] = x[i];
    const bf16x8_t h = __builtin_convertvector(v, bf16x8_t);
    const f32x8 hf = __builtin_convertvector(h, f32x8);
#pragma unroll
    for (int i = 0; i < 8; ++i) w[i] = x[i] - hf[i];
    hi = __builtin_bit_cast(bf16x8, h); lo = pack8(w);
}
__device__ __forceinline__ s16x4 rev4(s16x4 v) { return __builtin_shufflevector(v, v, 3, 2, 1, 0); }

struct GlaCtx { int R0, n, nc, dir, h, cbase; };
__device__ __forceinline__ int gla_row(const GlaCtx& g, int tau) { return g.R0 + (g.dir ? g.n - 1 - tau : tau); }
__device__ __forceinline__ unsigned char* gla_blk(const Frame& F, const GlaCtx& g, int c) { return F.GSC + (size_t)(g.cbase + c) * GC_BYTES + g.dir * GC_DIR; }
__device__ __forceinline__ bf16x8 gla_vfrag(const Frame& F, const GlaCtx& g, int c, int jt, int st, int sp, int r, int hh) {
    const int tau = 64 * c + 32 * st + 16 * sp + 4 * hh;
    const bf16_t* p = F.VGT + (size_t)(g.h * 128 + jt * 32 + r) * NT + g.R0 + (g.dir ? g.n - 4 - tau : tau);
    s16x4 lo = *(const s16x4*)p, hi = *(const s16x4*)(p + (g.dir ? -8 : 8));
    if (g.dir) { lo = rev4(lo); hi = rev4(hi); }
    return __builtin_shufflevector(lo, hi, 0, 1, 2, 3, 4, 5, 6, 7);
}

__device__ __forceinline__ void gla_step1(const Frame& F, const GlaCtx& g, int c, LAS unsigned char* wl, int lane) {
    asm volatile("" : "+v"(lane));
    const int r = lane & 31, hh = lane >> 5, h = g.h, dir = g.dir;
    unsigned char* blk = gla_blk(F, g, c);
    bf16x8 Ltri[2], Lone, Iden[2];
#pragma unroll
    for (int jj = 0; jj < 8; ++jj) Lone[jj] = (short)0x3F80;
#pragma unroll
    for (int sp = 0; sp < 2; ++sp)
#pragma unroll
        for (int jj = 0; jj < 8; ++jj) {
            const int s = 16 * sp + 8 * (jj >> 2) + 4 * hh + (jj & 3); Ltri[sp][jj] = (s <= r) ? (short)0x3F80 : (short)0;
            Iden[sp][jj] = (16 * sp + 8 * hh + jj == r) ? (short)0x3F80 : (short)0;
        }
#pragma unroll 1
    for (int kt = 0; kt < 2; ++kt) {
        int ln = lane; asm volatile("" : "+v"(ln));
        const int r = ln & 31, hh = ln >> 5; const int lane = ln;
        bf16x8 whi, wlo;
        {
            float w[8];
#pragma unroll
            for (int jj = 0; jj < 8; ++jj) w[jj] = F.w_alpha[(size_t)(dir * 16 + 8 * hh + jj) * 256 + h * 64 + 32 * kt + r];
            split8(w, whi, wlo);
        }
        const float bias = F.b_alpha[dir * 256 + h * 64 + 32 * kt + r];
        bf16x8 ghi[2][2], glo[2][2];
#pragma unroll
        for (int tt = 0; tt < 2; ++tt) {
            const float* lp = F.LR + (size_t)gla_row(g, 64 * c + 32 * tt + r) * 32 + dir * 16 + 8 * hh;
            const float4 l0 = *(const float4*)lp, l1 = *(const float4*)(lp + 4);
            const float lx[8] = {l0.x, l0.y, l0.z, l0.w, l1.x, l1.y, l1.z, l1.w};
            bf16x8 ahi, alo; split8(lx, ahi, alo);
            f32x16 z = MFMA32(ahi, whi, zero16()); z = MFMA32(alo, whi, z); z = MFMA32(ahi, wlo, z);
            float gv[16];
#pragma unroll
            for (int i = 0; i < 16; ++i) {
                const float zz = z[i] + bias;
                const float sp = __builtin_amdgcn_logf(1.0f + __builtin_amdgcn_exp2f(-fabsf(zz) * LOG2E)) * 0.6931471805599453f;
                gv[i] = (fminf(zz, 0.f) - sp) * 0.0625f;
            }
#pragma unroll
            for (int sp = 0; sp < 2; ++sp) { float x[8]; _Pragma("unroll") for (int jj = 0; jj < 8; ++jj) x[jj] = gv[8 * sp + jj]; split8(x, ghi[tt][sp], glo[tt][sp]); }
        }
        asm volatile("" ::: "memory");
        f32x16 bb[2];
        {
            f32x16 a = zero16(), d = zero16();
#pragma unroll
            for (int sp = 0; sp < 2; ++sp) { a = MFMA32(Ltri[sp], ghi[0][sp], a); a = MFMA32(Ltri[sp], glo[0][sp], a); }
#pragma unroll
            for (int sp = 0; sp < 2; ++sp) { d = MFMA32(Lone, ghi[0][sp], d); d = MFMA32(Lone, glo[0][sp], d); d = MFMA32(Ltri[sp], ghi[1][sp], d); d = MFMA32(Ltri[sp], glo[1][sp], d); }
            bb[0] = a; bb[1] = d;
        }
        float blast;
        { const float x = bb[1][15]; const float y = __shfl_xor(x, 32); blast = hh ? x : y; }
        {
            float* BT = (float*)(blk + GC_BT);
#pragma unroll
            for (int tt = 0; tt < 2; ++tt)
#pragma unroll
                for (int i = 0; i < 16; ++i) BT[((tt * 2 + kt) * 16 + i) * 64 + lane] = bb[tt][i];
            if (hh == 0) { float* BL = (float*)(blk + GC_BL); BL[32 * kt + r] = blast; }
        }
        asm volatile("" ::: "memory");
        bf16x8 khat[2][2];
#pragma unroll
        for (int st = 0; st < 2; ++st) {
            const bf16_t* kp = F.KG + (size_t)gla_row(g, 64 * c + 32 * st + r) * 256 + h * 64 + 32 * kt + 8 * hh;
            f32x16 ka = MFMA32(*(const bf16x8*)(kp), Iden[0], zero16()); ka = MFMA32(*(const bf16x8*)(kp + 16), Iden[1], ka);
            float kh[16];
#pragma unroll
            for (int i = 0; i < 16; ++i) {
                const float bv = bb[st][i];
                kh[i] = ka[i] * __builtin_amdgcn_exp2f((blast - bv) * LOG2E);
                *(LAS unsigned short*)(wl + (32 * st + crow(i, hh)) * GL_LROW + r * 2) = (unsigned short)f2bf(ka[i] * __builtin_amdgcn_exp2f(-bv * LOG2E));
            }
#pragma unroll
            for (int sp = 0; sp < 2; ++sp) { f32x8 x; _Pragma("unroll") for (int jj = 0; jj < 8; ++jj) x[jj] = kh[8 * sp + jj]; khat[st][sp] = pack8(x); }
        }
        {
            bf16_t* KT = (bf16_t*)(blk + GC_KT);
#pragma unroll
            for (int i = 0; i < 4; ++i) { const int row = 16 * i + (lane >> 2), ch = lane & 3; *(u32x4*)(KT + row * 64 + 32 * kt + ch * 8) = *(const LAS u32x4*)(wl + row * GL_LROW + ch * 16); }
        }
        asm volatile("" ::: "memory");
#pragma unroll
        for (int tt = 0; tt < 2; ++tt) {
            const bf16_t* qp = F.QG + (size_t)gla_row(g, 64 * c + 32 * tt + r) * 256 + h * 64 + 32 * kt + 8 * hh;
            f32x16 qa = MFMA32(*(const bf16x8*)(qp), Iden[0], zero16()); qa = MFMA32(*(const bf16x8*)(qp + 16), Iden[1], qa);
#pragma unroll
            for (int i = 0; i < 16; ++i)
                *(LAS unsigned short*)(wl + (32 * tt + crow(i, hh)) * GL_LROW + r * 2) = (unsigned short)f2bf(qa[i] * __builtin_amdgcn_exp2f(bb[tt][i] * LOG2E));
        }
        {
            bf16_t* QT = (bf16_t*)(blk + GC_QT);
#pragma unroll
            for (int i = 0; i < 4; ++i) { const int row = 16 * i + (lane >> 2), ch = lane & 3; *(u32x4*)(QT + row * 64 + 32 * kt + ch * 8) = *(const LAS u32x4*)(wl + row * GL_LROW + ch * 16); }
        }
        float* DS = (float*)(blk + GC_DS);
#pragma unroll
        for (int jt = 0; jt < 4; ++jt) {
            asm volatile("" ::: "memory");
            f32x16 d0 = zero16();
#pragma unroll
            for (int st = 0; st < 2; ++st)
#pragma unroll
                for (int sp = 0; sp < 2; ++sp) d0 = MFMA32(gla_vfrag(F, g, c, jt, st, sp, r, hh), khat[st][sp], d0);
#pragma unroll
            for (int i = 0; i < 16; ++i) DS[((jt * 2 + kt) * 16 + i) * 64 + lane] = d0[i];
        }
    }
}

__device__ __forceinline__ void gla_scan(const Frame& F, const GlaCtx& g, int grp, int b, int tid) {
    asm volatile("" : "+v"(tid));
    float S[2][8];
#pragma unroll
    for (int q = 0; q < 2; ++q) {
        const int p = tid + 512 * q, j = p >> 3, k8 = (p & 7) * 8;
        if (grp == 0) { _Pragma("unroll") for (int e = 0; e < 8; ++e) S[q][e] = 0.f; }
        else { const float* st = (g.dir == 0 ? F.st_f : F.st_b) + (size_t)(b * 4 + g.h) * 8192; _Pragma("unroll") for (int e = 0; e < 8; ++e) S[q][e] = st[(k8 + e) * 128 + j]; }
    }
    for (int c = 0; c < g.nc; ++c) {
        unsigned char* blk = gla_blk(F, g, c);
        const float* DS = (const float*)(blk + GC_DS); const float* BL = (const float*)(blk + GC_BL); bf16_t* SC = (bf16_t*)(blk + GC_SC);
#pragma unroll
        for (int q = 0; q < 2; ++q) {
            const int p = tid + 512 * q, j = p >> 3, k8 = (p & 7) * 8;
            const int jt = j >> 5, jr = j & 31, ks = k8 >> 4, khh = (k8 >> 3) & 1;
            u32x4 w; w.x = pk2(S[q][0], S[q][1]); w.y = pk2(S[q][2], S[q][3]); w.z = pk2(S[q][4], S[q][5]); w.w = pk2(S[q][6], S[q][7]);
            *(u32x4*)(SC + ((((jt * 4 + ks) * 2 + khh) * 32 + jr) * 8)) = w;
            const int jhh = (jr >> 2) & 1, ji = (jr & 3) + 4 * (jr >> 3), kt = k8 >> 5;
            const float* dp = DS + ((jt * 2 + kt) * 16 + ji) * 64 + jhh * 32 + (k8 & 31);
            const float4 d0 = *(const float4*)dp, d1 = *(const float4*)(dp + 4), b0 = *(const float4*)(BL + k8), b1 = *(const float4*)(BL + k8 + 4);
            const float dd[8] = {d0.x, d0.y, d0.z, d0.w, d1.x, d1.y, d1.z, d1.w}, bl[8] = {b0.x, b0.y, b0.z, b0.w, b1.x, b1.y, b1.z, b1.w};
#pragma unroll
            for (int e = 0; e < 8; ++e) S[q][e] = __builtin_amdgcn_exp2f(bl[e] * LOG2E) * S[q][e] + dd[e];
        }
    }
    if (grp == 0) {
        float* so = F.out + (g.dir == 0 ? O_SF : O_SB) + (size_t)(b * 4 + g.h) * 8192;
#pragma unroll
        for (int q = 0; q < 2; ++q) { const int p = tid + 512 * q, j = p >> 3, k8 = (p & 7) * 8; _Pragma("unroll") for (int e = 0; e < 8; ++e) so[(k8 + e) * 128 + j] = S[q][e]; }
    }
}

__device__ __forceinline__ void gla_step3(const Frame& F, const GlaCtx& g, int c, int lane) {
    asm volatile("" : "+v"(lane));
    const int r = lane & 31, hh = lane >> 5, h = g.h;
    unsigned char* blk = gla_blk(F, g, c);
    const bf16_t* QT = (const bf16_t*)(blk + GC_QT); const bf16_t* KT = (const bf16_t*)(blk + GC_KT); const bf16_t* SC = (const bf16_t*)(blk + GC_SC);
#pragma unroll 1
    for (int tt = 0; tt < 2; ++tt) {
        int ln = lane; asm volatile("" : "+v"(ln));
        const int r = ln & 31, hh = ln >> 5; const int lane = ln;
        bf16x8 qf[4];
#pragma unroll
        for (int ks = 0; ks < 4; ++ks) qf[ks] = *(const bf16x8*)(QT + (32 * tt + r) * 64 + 16 * ks + 8 * hh);
        f32x16 o[4];
#pragma unroll
        for (int jt = 0; jt < 4; ++jt) {
            asm volatile("" ::: "memory");
            f32x16 a = zero16();
#pragma unroll
            for (int ks = 0; ks < 4; ++ks) a = MFMA32(*(const bf16x8*)(SC + ((((jt * 4 + ks) * 2 + hh) * 32 + r) * 8)), qf[ks], a);
            o[jt] = a;
        }
#pragma unroll 1
        for (int st = 0; st <= tt; ++st) {
            f32x16 at = zero16();
#pragma unroll
            for (int ks = 0; ks < 4; ++ks) at = MFMA32(*(const bf16x8*)(KT + (32 * st + r) * 64 + 16 * ks + 8 * hh), qf[ks], at);
            bf16x8 pa[2];
#pragma unroll
            for (int sp = 0; sp < 2; ++sp) {
                f32x8 x;
#pragma unroll
                for (int jj = 0; jj < 8; ++jj) { const int i = 8 * sp + jj; x[jj] = (st < tt || crow(i, hh) <= r) ? at[i] : 0.f; }
                pa[sp] = pack8(x);
            }
#pragma unroll
            for (int sp = 0; sp < 2; ++sp) {
                asm volatile("" ::: "memory");
#pragma unroll
                for (int jt = 0; jt < 4; ++jt) o[jt] = MFMA32(gla_vfrag(F, g, c, jt, st, sp, r, hh), pa[sp], o[jt]);
            }
        }
        if (g.dir == 0) {
            float* OF = (float*)(F.GSC + (size_t)(g.cbase + c) * GC_BYTES + GC_OF);
#pragma unroll
            for (int jt = 0; jt < 4; ++jt)
#pragma unroll
                for (int i = 0; i < 16; ++i) OF[((tt * 4 + jt) * 16 + i) * 64 + lane] = o[jt][i];
        } else {
            const float* OF = (const float*)(F.GSC + (size_t)(g.cbase + g.nc - 1 - c) * GC_BYTES + GC_OF);
            float ss = 0.f;
#pragma unroll
            for (int jt = 0; jt < 4; ++jt) {
                asm volatile("" ::: "memory");
#pragma unroll
                for (int i = 0; i < 16; ++i) { o[jt][i] += OF[(((1 - tt) * 4 + jt) * 16 + i) * 64 + hh * 32 + (31 - r)]; ss += o[jt][i] * o[jt][i]; }
            }
            ss += __shfl_xor(ss, 32);
            const float rstd = 1.0f / sqrtf(ss * (1.0f / 128.0f) + 1e-6f);
            const int row = gla_row(g, 64 * c + 32 * tt + r);
            const bf16_t* sg = F.SG + (size_t)row * 1024 + h * 128; bf16_t* dst = F.MGB + (size_t)row * 1024 + h * 128;
#pragma unroll
            for (int jt = 0; jt < 4; ++jt)
#pragma unroll
                for (int q = 0; q < 4; ++q) {
                    const int j = 32 * jt + 8 * q + 4 * hh;
                    const uint2 gw = *(const uint2*)(sg + j); const float4 gn = *(const float4*)(F.gla_gain + j);
                    uint2 w;
                    w.x = pk2(o[jt][4 * q + 0] * rstd * gn.x * bf2f((unsigned short)(gw.x & 0xffffu)), o[jt][4 * q + 1] * rstd * gn.y * bf2f((unsigned short)(gw.x >> 16)));
                    w.y = pk2(o[jt][4 * q + 2] * rstd * gn.z * bf2f((unsigned short)(gw.y & 0xffffu)), o[jt][4 * q + 3] * rstd * gn.w * bf2f((unsigned short)(gw.y >> 16)));
                    *(uint2*)(dst + j) = w;
                }
        }
    }
}

__device__ __forceinline__ void gla_item(const Frame& F, LAS unsigned char* lds, int grp, int b, int h, int cbase) {
    int tid = F.tid; asm volatile("" : "+v"(tid));
    const int lane = tid & 63, wave = __builtin_amdgcn_readfirstlane(tid >> 6);
    GlaCtx g; g.R0 = grp == 0 ? b * 256 : NPR + b * 1024; g.n = grp == 0 ? 256 : 1024; g.nc = g.n >> 6; g.h = h; g.cbase = cbase;
    LAS unsigned char* wl = lds + wave * GL_LWAVE;
    for (int dir = 0; dir < 2; ++dir) {
        g.dir = dir;
        for (int c = wave; c < g.nc; c += 8) gla_step1(F, g, c, wl, lane);
        asm volatile("s_waitcnt vmcnt(0)" ::: "memory"); __syncthreads();
        gla_scan(F, g, grp, b, tid);
        asm volatile("s_waitcnt vmcnt(0)" ::: "memory"); __syncthreads();
        for (int c = wave; c < g.nc; c += 8) gla_step3(F, g, c, lane);
        asm volatile("s_waitcnt vmcnt(0)" ::: "memory"); __syncthreads();
    }
}
__device__ __forceinline__ void mixer_item(const Frame& F, LAS unsigned char* lds, int item, float lam) {
    const bool is_gla = item < 8 || (item >= 72 && item < 136);
    if (is_gla) {
        int grp, b, h, cbase;
        if (item < 8) { grp = 1; b = item >> 2; h = item & 3; cbase = item * 16; } else { const int it = item - 72; grp = 0; b = it >> 2; h = it & 3; cbase = 128 + it * 4; }
        gla_item(F, lds, grp, b, h, cbase);
    } else {
        int grp, b, h, qb;
        if (item < 72) { const int it = item - 8; grp = 1; b = it >> 5; h = (it >> 3) & 3; qb = it & 7; } else { const int it = item - 136; grp = 0; b = it >> 3; h = (it >> 1) & 3; qb = it & 1; }
        attn_item(F, lds, grp, b, h, qb, lam);
    }
}
__device__ __forceinline__ void ph_mixers(const Frame& F, LAS unsigned char* lds) {
    const float lam = __builtin_bit_cast(float, __builtin_amdgcn_readfirstlane(__builtin_bit_cast(int, lam_value(F))));
    constexpr int NITEM = 264;
    for (int k = 0; ; ++k) {
        const int item = (k & 1) ? (k + 1) * F.G - 1 - F.bid : k * F.G + F.bid;
        if (k * F.G >= NITEM) break;
        if (item < NITEM) mixer_item(F, lds, item, lam);
    }
}

__device__ void ph_merge(const Frame& F) {
    for (int r = F.bid * 8 + F.wave; r < NT; r += F.G * 8) {
#pragma unroll
        for (int g = 0; g < 1; ++g)
#pragma unroll
            for (int h = 0; h < 4; ++h) {
                const int c = h * 128 + F.lane * 2;
                float2 v;
                if (g == 0) { const float2 a = *(const float2*)(F.OGF + (size_t)r * 512 + c), bb = *(const float2*)(F.OGB + (size_t)r * 512 + c); v.x = a.x + bb.x; v.y = a.y + bb.y; }
                else v = *(const float2*)(F.OD + (size_t)r * 512 + c);
                const float ss = wave_sum(v.x * v.x + v.y * v.y);
                const float rstd = 1.0f / sqrtf(ss * (1.0f / 128.0f) + 1e-6f);
                const float* gain = (g == 0 ? F.gla_gain : F.diff_gain) + F.lane * 2;
                const float sc = g == 0 ? 1.0f : 0.8f;
                const float2 gt = *(const float2*)(F.P + (size_t)r * PW + C_GATE + g * 512 + c);
                float2 o; o.x = v.x * rstd * gain[0] * sc * silu_f(gt.x); o.y = v.y * rstd * gain[1] * sc * silu_f(gt.y);
                *(unsigned*)(F.MGB + (size_t)r * D + g * 512 + c) = pk2(o.x, o.y);
            }
    }
}
__device__ __forceinline__ void ph_final(const Frame& F) {
    for (int r = F.bid * 8 + F.wave; r < NT; r += F.G * 8) {
        float* y = F.out + (size_t)r * D;
        float4 v[4]; float ss = 0.f;
#pragma unroll
        for (int i = 0; i < 4; ++i) { v[i] = *(const float4*)(y + i * 256 + F.lane * 4); ss += v[i].x * v[i].x + v[i].y * v[i].y + v[i].z * v[i].z + v[i].w * v[i].w; }
        ss = wave_sum(ss);
        const float rstd = 1.0f / sqrtf(ss * (1.0f / 1024.0f) + 1e-6f);
#pragma unroll
        for (int i = 0; i < 4; ++i) {
            const int k = i * 256 + F.lane * 4; const float4 g = *(const float4*)(F.final_gain + k);
            float4 o; o.x = v[i].x * rstd * g.x; o.y = v[i].y * rstd * g.y; o.z = v[i].z * rstd * g.z; o.w = v[i].w * rstd * g.w;
            *(float4*)(y + k) = o;
        }
    }
}


__device__ __forceinline__ void frame_derive(Frame& F, unsigned char* ws) {
    asm volatile("" : "+s"(ws));
    F.ws = ws;
    F.MOD = (float*)(ws + WS_MOD); F.H = nullptr; F.P = (float*)(ws + WS_P);
    F.OGF = (float*)(ws + WS_OGF); F.OGB = (float*)(ws + WS_OGB); F.OD = (float*)(ws + WS_OD); F.MG = (float*)(ws + WS_MG);
    F.ROPE = (float*)(ws + WS_ROPE); F.LR = (float*)(ws + WS_LR);
    F.WINT = (bf16_t*)(ws + WS_WINT); F.WOT = (bf16_t*)(ws + WS_WOT); F.HB = (bf16_t*)(ws + WS_HB); F.QG = (bf16_t*)(ws + WS_QG); F.KG = (bf16_t*)(ws + WS_KG); F.VG = (bf16_t*)(ws + WS_VG);
    F.DQ = (bf16_t*)(ws + WS_DQ); F.DKP = (bf16_t*)(ws + WS_DKP); F.DVP = (bf16_t*)(ws + WS_DVP); F.DKS = (bf16_t*)(ws + WS_DKS); F.DVS = (bf16_t*)(ws + WS_DVS);
    F.SG = (bf16_t*)(ws + WS_SG); F.MGB = (bf16_t*)(ws + WS_MGB); F.VGT = (bf16_t*)(ws + WS_VGT); F.GSC = ws + WS_GSC;
}

#ifndef DEBUG_P
#define DEBUG_P 0
#endif
constexpr int NPH = 6;
__global__ void __launch_bounds__(NTHR, 2) mega(Args args) {
    extern __shared__ __attribute__((aligned(16))) unsigned char lds_raw[];
    LAS unsigned char* lds = (LAS unsigned char*)lds_raw;
    Frame F;
    F.x_prompt = args.in[0]; F.x_sample = args.in[1]; F.cache_k = args.in[2]; F.cache_v = args.in[3]; F.st_f = args.in[4]; F.st_b = args.in[5];
    F.c = args.in[6]; F.c_ctx = args.in[7]; F.norm_gain = args.in[8]; F.w_mod = args.in[9]; F.b_mod = args.in[10]; F.w_in = args.in[11];
    F.w_alpha = args.in[12]; F.b_alpha = args.in[13]; F.dlam = args.in[14]; F.gla_gain = args.in[15]; F.diff_gain = args.in[16]; F.w_out = args.in[17]; F.final_gain = args.in[18];
    F.out = args.out; F.ws = args.ws;
    unsigned char* ws = args.ws;
    F.tid = threadIdx.x; F.lane = F.tid & 63; F.wave = F.tid >> 6; F.G = gridDim.x; F.bid = blockIdx.x;
    volatile LAS unsigned* misc = (volatile LAS unsigned*)(lds + LDS_BYTES - 64);
    if (F.tid < 16) misc[F.tid] = 0u;
    __syncthreads();
    const int lo = args.ph_lo, hi = args.ph_hi;
    XcdBarrier bar; bar.bar = (unsigned*)(ws + WS_CTL) + 1024; bar.x = 0; bar.st = nullptr;
    if (hi - lo > 1) bar = xcd_barrier_post((unsigned*)(ws + WS_CTL) + 1024, misc);
#define IN(k) (lo <= (k) && (k) < hi)
#define SEAM(k) do { if (IN(k) && IN((k) + 1)) xcd_barrier(bar); } while (0)
    LAS float* ldsf = (LAS float*)lds;
    if (IN(0)) { frame_derive(F, ws); ph_prep(F, lds); } SEAM(0);
    if (IN(1)) { frame_derive(F, ws); ph_hb(F); } SEAM(1);
    if (IN(2)) {
        frame_derive(F, ws);
        pg8::Gemm g{F.HB, F.WINT, NT, NIN, D}; pg8::StaticOrder S; S.init(NT, NIN, F.G, F.bid);
        EpiInFast E{F.QG, F.KG, F.VGT, F.DQ, F.DKP, F.DVP, F.DKS, F.DVS, F.SG, F.LR, F.out, F.ROPE, DEBUG_P ? F.P : nullptr};
        pg8::gemm_phase<EpiInFast, pg8::StaticOrder, true, true>(lds, g, S, E);
    } SEAM(2);
    if (IN(3)) { frame_derive(F, ws); ph_mixers(F, lds); } SEAM(3);
    if (IN(4)) {
        frame_derive(F, ws);
        pg8::Gemm g{F.MGB, F.WOT, NT, D, D}; pg8::StaticOrder S; S.init(NT, D, F.G, F.bid);
        EpiOutFast E{F.x_prompt, F.x_sample, F.MOD, F.out};
        pg8::gemm_phase<EpiOutFast, pg8::StaticOrder, true, true>(lds, g, S, E);
    } SEAM(4);
    if (IN(5)) { frame_derive(F, ws); ph_final(F); }
#undef IN
#undef SEAM
}

extern "C" void kernel_launch(void* const* d_in, const int* in_sizes, int n_in, void* d_out, int out_size, void* d_ws, size_t ws_size, hipStream_t stream) {
    static int grid = 0;
    if (grid == 0) {
        if (n_in != 19 || out_size != 11534336 || ws_size < WS_END) { fprintf(stderr, "kernel_launch: unexpected shapes n_in %d out %d ws %zu\n", n_in, out_size, ws_size); grid = -1; return; }
        int dev = 0, cus = 0;
        if (hipGetDevice(&dev) != hipSuccess || hipDeviceGetAttribute(&cus, hipDeviceAttributeMultiprocessorCount, dev) != hipSuccess) { grid = -1; return; }
        if (hipFuncSetAttribute((const void*)mega, hipFuncAttributeMaxDynamicSharedMemorySize, LDS_BYTES) != hipSuccess) { fprintf(stderr, "kernel_launch: hipFuncSetAttribute failed\n"); grid = -1; return; }
        grid = cus;
    }
    if (grid < 0) return;
    (void)hipMemsetAsync((char*)d_ws + WS_CTL, 0, CTL_ZERO_BYTES, stream);
    Args a{};
    for (int i = 0; i < 19; ++i) a.in[i] = (const float*)d_in[i];
    a.out = (float*)d_out; a.ws = (unsigned char*)d_ws;
    if (MK_N_LAUNCHES == 1) {
        a.ph_lo = 0; a.ph_hi = NPH;
        hipLaunchKernelGGL(mega, dim3(grid), dim3(NTHR), LDS_BYTES, stream, a);
    } else {
        for (int p = 0; p < NPH; ++p) { a.ph_lo = p; a.ph_hi = p + 1; hipLaunchKernelGGL(mega, dim3(grid), dim3(NTHR), LDS_BYTES, stream, a); }
    }
}
```

```cpp
#include <hip/hip_runtime.h>
#include <cstdio>
#include <cstdint>

#ifndef MK_N_LAUNCHES
#define MK_N_LAUNCHES 1
#endif

constexpr int D = 1024, NPR = 4096, NSR = 2048, NT = 6144, PW = 3616;
constexpr int C_GQ = 0, C_GK = 256, C_GV = 512, C_LRF = 1024, C_LRB = 1040, C_DQ = 1056, C_DK = 1568, C_DV = 2080, C_GATE = 2592;
constexpr size_t O_Y = 0, O_NK = 6291456, O_NV = 8388608, O_SF = 10485760, O_SB = 11010048;
constexpr int NTHR = 512;
constexpr int LDS_BYTES = 147456;

constexpr size_t MiB = 1u << 20;
constexpr size_t WS_CTL = 0, CTL_ZERO_BYTES = 64 * 1024;
constexpr size_t WS_MOD = 24576;
constexpr size_t WS_ROPE = 64 * 1024;
constexpr size_t WS_WINT = 1 * MiB;
constexpr size_t WS_WOT = 9 * MiB;
constexpr size_t WS_HB = 12 * MiB;
constexpr size_t WS_QG = 24 * MiB, WS_KG = 27 * MiB;
constexpr size_t WS_VG = 30 * MiB;
constexpr size_t WS_DQ = 36 * MiB;
constexpr size_t WS_DKP = 42 * MiB, WS_DVP = 46 * MiB;
constexpr size_t WS_DKS = 50 * MiB, WS_DVS = 53 * MiB;
constexpr size_t WS_SG = 56 * MiB;
constexpr size_t WS_LR = 68 * MiB;
constexpr size_t WS_MGB = 70 * MiB;
constexpr size_t WS_VGT = 82 * MiB;
constexpr size_t WS_GSC = 90 * MiB;
constexpr size_t WS_P = 84 * MiB;
constexpr size_t WS_OGF = 170 * MiB;
constexpr size_t WS_OGB = 182 * MiB;
constexpr size_t WS_OD = 194 * MiB;
constexpr size_t WS_MG = 206 * MiB;
constexpr size_t WS_END = 230 * MiB;
constexpr int NIN = 3840;

#define LAS __attribute__((address_space(3)))

#define XB_TMO      128
#define XB_XCNT(j)  (256  + 64 * (j))
#define XB_XSUB(j)  (1280 + 64 * (j))
#define XB_XGEN(j)  (2304 + 64 * (j))
#define XB_TOP      3328
#define XB_TOPGEN   3392
#define XCD_BAR_WORDS 3456
#define XB_SPIN_CAP (1u << 18)
__device__ __forceinline__ unsigned xb_ld(unsigned* p)              { return __hip_atomic_load(p, __ATOMIC_RELAXED, __HIP_MEMORY_SCOPE_AGENT); }
__device__ __forceinline__ unsigned xb_add(unsigned* p, unsigned v) { return __hip_atomic_fetch_add(p, v, __ATOMIC_RELAXED, __HIP_MEMORY_SCOPE_AGENT); }
__device__ __forceinline__ unsigned xb_xcc_id() { return (unsigned)__builtin_amdgcn_s_getreg((3 << 11) | 20) & 0xFu; }
#define XB_SPIN(cond, bar) do { unsigned _sp = 0; while (cond) { __builtin_amdgcn_s_sleep(1); \
    if ((++_sp & 255u) == 0u) { if (xb_ld(&(bar)[XB_TMO])) break; if (_sp > XB_SPIN_CAP) { atomicAdd(&(bar)[XB_TMO], 1u); break; } } } } while (0)
struct XcdBarrier { unsigned* bar; unsigned x; volatile LAS unsigned* st; };
__device__ __forceinline__ XcdBarrier xcd_barrier_post(unsigned* bar, volatile LAS unsigned* st) {
    XcdBarrier b; b.bar = bar; b.x = xb_xcc_id(); b.st = st;
    if (threadIdx.x == 0) (void)xb_add(&bar[XB_XCNT(b.x)], 1u);
    return b;
}
__device__ __forceinline__ void xcd_barrier_complete(unsigned* bar, unsigned x, unsigned& nloc, unsigned& nx) {
    const unsigned G = gridDim.x * gridDim.y * gridDim.z;
    unsigned sum, cnt, mine, sp = 0u;
    for (;;) {
        sum = 0u; cnt = 0u; mine = 0u;
#pragma unroll
        for (unsigned j = 0; j < 16; ++j) { const unsigned c = xb_ld(&bar[XB_XCNT(j)]); sum += c; cnt += (c > 0u) ? 1u : 0u; mine = (j == x) ? c : mine; }
        if (sum == G) break;
        __builtin_amdgcn_s_sleep(1);
        if ((++sp & 255u) == 0u) { if (xb_ld(&bar[XB_TMO])) break; if (sp > XB_SPIN_CAP) { atomicAdd(&bar[XB_TMO], 1u); break; } }
    }
    nloc = mine > 0u ? mine : 1u; nx = cnt > 0u ? cnt : 1u;
}
__device__ __forceinline__ void xcd_barrier(const XcdBarrier& b) {
    asm volatile("s_waitcnt vmcnt(0)" ::: "memory");
    __syncthreads();
    if (threadIdx.x == 0) {
        unsigned* bar = b.bar;
        __builtin_amdgcn_s_waitcnt(0);
        unsigned nloc = b.st[0], nx = b.st[1];
        if (nloc == 0u) { xcd_barrier_complete(bar, b.x, nloc, nx); b.st[0] = nloc; b.st[1] = nx; }
        const unsigned old = xb_add(&bar[XB_XSUB(b.x)], 1u);
        const unsigned gen = old / nloc;
        if (old + 1u == (gen + 1u) * nloc) {
            __builtin_amdgcn_fence(__ATOMIC_RELEASE, "agent");
            asm volatile("s_waitcnt vmcnt(0)" ::: "memory");
            const unsigned og = xb_add(&bar[XB_TOP], 1u);
            const unsigned tg = og / nx;
            if (og + 1u == (tg + 1u) * nx) xb_add(&bar[XB_TOPGEN], 1u);
            else XB_SPIN(xb_ld(&bar[XB_TOPGEN]) == tg, bar);
            __builtin_amdgcn_fence(__ATOMIC_ACQUIRE, "agent");
            xb_add(&bar[XB_XGEN(b.x)], 1u);
            asm volatile("s_waitcnt vmcnt(0)" ::: "memory");
        } else {
            XB_SPIN(xb_ld(&bar[XB_XGEN(b.x)]) == gen, bar);
            __builtin_amdgcn_fence(__ATOMIC_ACQUIRE, "agent");
            asm volatile("s_waitcnt vmcnt(0)" ::: "memory");
        }
    }
    __syncthreads();
}

namespace pg8 {
#define PG8_LAS __attribute__((address_space(3)))
typedef unsigned short bf16_t;
typedef short bf16x8 __attribute__((ext_vector_type(8)));
typedef float f32x4 __attribute__((ext_vector_type(4)));
typedef unsigned u32x4 __attribute__((ext_vector_type(4)));
constexpr int BM = 256, BK = 64, HALF = 128, HTB = HALF * BK * 2  , STAGE_BYTES = 8 * HTB, NXCD = 8, WGM = 8;

__host__ __device__ __forceinline__ int lds_byte(int r, int c) { const int st = (r >> 4) * 2 + (c >> 5), rr = r & 15, cc = c & 31, ob = rr * 64 + cc * 2; return st * 1024 + (ob ^ (((ob >> 9) & 1) << 5)); }
__host__ __device__ __forceinline__ void stage_rc(int b, int& R, int& C) { const int st = b / 1024, sb = b % 1024, swz = sb ^ (((sb >> 9) & 1) << 5); R = (st >> 1) * 16 + swz / 64; C = (st & 1) * 32 + (swz % 64) / 2; }
__host__ __device__ __forceinline__ int perm32(int rho) { const int n = rho >> 4, i = rho & 15; return 8 * (i >> 2) + 4 * n + (i & 3); }

struct Unit { int pm, pn; };
struct Gemm { const bf16_t* A; const bf16_t* Bt; int M, N, K; };

struct StaticOrder {
    int nM, nN, nwg, G, c;
    __host__ __device__ void init(int M, int N, int G_, int c_) { nM = M / BM; nN = N / BM; nwg = nM * nN; G = G_; c = c_; }
    __host__ __device__ bool next(int i, Unit& u) const {
        const long L = (long)i * G + c; if (L >= nwg) return false;
        int wgid = (int)L; { const int q = nwg / NXCD, r = nwg % NXCD, xcd = wgid % NXCD, off = wgid / NXCD; wgid = (xcd < r ? xcd * (q + 1) : r * (q + 1) + (xcd - r) * q) + off; }
        const int nig = WGM * nN, gid = wgid / nig, fm = gid * WGM, gsz = (nM - fm) < WGM ? (nM - fm) : WGM;
        u.pm = fm + ((wgid % nig) % gsz); u.pn = (wgid % nig) / gsz; return true;
    }
    __device__ __forceinline__ void a_ready(const Unit&) const {}
    __device__ __forceinline__ void done(const Unit&) const {}
};

__device__ __forceinline__ unsigned cvt_pk_bf16(float lo, float hi) { unsigned r; asm volatile("v_cvt_pk_bf16_f32 %0, %1, %2" : "=v"(r) : "v"(lo), "v"(hi)); return r; }
template <class Epi, class Sched, bool ALIGN_EPI = false, bool SP2 = false>
__device__ __forceinline__ void gemm_phase(PG8_LAS unsigned char* lds, const Gemm g, const Sched& S, const Epi& E) {
    const int tid = threadIdx.x, wid = __builtin_amdgcn_readfirstlane(tid >> 6), lane = tid & 63, wr = wid >> 2, wc = wid & 3, fr = lane & 15, fq = lane >> 4;
    const int K = g.K, nt = K / BK;
    unsigned voffA[2], voffB[2];
#pragma unroll
    for (int i = 0; i < 2; ++i) { int R, C; stage_rc(tid * 16 + i * 8192, R, C); const int Rb = Epi::PERM ? ((R & ~31) + perm32(R & 31)) : R;
        voffA[i] = (unsigned)(R * K + C) * 2u; voffB[i] = (unsigned)(Rb * K + C) * 2u; }
    const size_t kstep = (size_t)(BK * 2);
    const size_t hstep = (size_t)HALF * K * 2;
    const size_t tstep = 2 * hstep;
    const unsigned ldsw = (unsigned)wid * 1024u;
    const int aoff = lds_byte(wr * 64 + fr, fq * 8), boff = lds_byte(wc * 32 + fr, fq * 8);
#define PG8_SA(b, h) (((b) * 2 + (h)) * HTB)
#define PG8_SB(b, h) ((4 + (b) * 2 + (h)) * HTB)
#define PG8_STAGE(bufoff, gbase, voff) do { _Pragma("unroll") for (int _i = 0; _i < 2; ++_i) \
        __builtin_amdgcn_global_load_lds((const unsigned*)((const char*)(gbase) + (voff)[_i]), (PG8_LAS unsigned*)(lds + (bufoff) + ldsw + _i * 8192), 16, 0, 0); } while (0)
#define PG8_LDA(dst, b, h) do { _Pragma("unroll") for (int m = 0; m < 4; ++m) _Pragma("unroll") for (int k = 0; k < 2; ++k) dst[m][k] = *(const PG8_LAS bf16x8*)(lds + PG8_SA(b, h) + aoff + m * 2048 + k * 1024); } while (0)
#define PG8_LDB(dst, b, h) do { _Pragma("unroll") for (int n = 0; n < 2; ++n) _Pragma("unroll") for (int k = 0; k < 2; ++k) dst[n][k] = *(const PG8_LAS bf16x8*)(lds + PG8_SB(b, h) + boff + n * 2048 + k * 1024); } while (0)
#define PG8_MMA(ai, bj, At, Bt) do { __builtin_amdgcn_s_setprio(1); _Pragma("unroll") for (int m = 0; m < 4; ++m) _Pragma("unroll") for (int n = 0; n < 2; ++n) _Pragma("unroll") for (int k = 0; k < 2; ++k) \
        acc[ai][bj][m][n] = __builtin_amdgcn_mfma_f32_16x16x32_bf16(Bt[n][k], At[m][k], acc[ai][bj][m][n], 0, 0, 0); __builtin_amdgcn_s_setprio(0); } while (0)
#define PG8_WAIT_V(n) asm volatile("s_waitcnt vmcnt(" #n ")" ::: "memory")
#define PG8_WAIT_L(n) asm volatile("s_waitcnt lgkmcnt(" #n ")" ::: "memory")
#define PG8_BAR __builtin_amdgcn_s_barrier()
#define PG8_SCHED __builtin_amdgcn_sched_barrier(0)
    Unit cur, nxt; int ui = 0;
    if (!S.next(0, cur)) return;
    f32x4 acc[2][2][4][2];
#pragma unroll
    for (int a = 0; a < 2; ++a)
#pragma unroll
        for (int b = 0; b < 2; ++b)
#pragma unroll
            for (int m = 0; m < 4; ++m)
#pragma unroll
                for (int n = 0; n < 2; ++n) acc[a][b][m][n] = (f32x4){0.f, 0.f, 0.f, 0.f};
    bf16x8 At[4][2], B0[2][2], B1[2][2];
    const char* cA = (const char*)g.A + (size_t)cur.pm * tstep; const char* cB = (const char*)g.Bt + (size_t)cur.pn * tstep;
    S.a_ready(cur);
    if constexpr (SP2) {
        PG8_STAGE(PG8_SB(0, 0), cB, voffB); PG8_STAGE(PG8_SB(0, 1), cB + hstep, voffB); PG8_STAGE(PG8_SA(0, 0), cA, voffA); PG8_STAGE(PG8_SA(0, 1), cA + hstep, voffA);
        if (wr == 1) PG8_BAR;
        PG8_WAIT_V(2); PG8_BAR;
        PG8_STAGE(PG8_SB(1, 0), cB + kstep, voffB); PG8_STAGE(PG8_SA(1, 0), cA + kstep, voffA); PG8_STAGE(PG8_SB(1, 1), cB + hstep + kstep, voffB);
        PG8_WAIT_V(6); PG8_BAR;
    } else {
        PG8_STAGE(PG8_SB(0, 0), cB, voffB); PG8_STAGE(PG8_SA(0, 0), cA, voffA); PG8_STAGE(PG8_SB(0, 1), cB + hstep, voffB); PG8_STAGE(PG8_SA(0, 1), cA + hstep, voffA);
        if (wr == 1) PG8_BAR;
        PG8_WAIT_V(4); PG8_BAR;
        PG8_STAGE(PG8_SB(1, 0), cB + kstep, voffB); PG8_STAGE(PG8_SA(1, 0), cA + kstep, voffA); PG8_STAGE(PG8_SB(1, 1), cB + hstep + kstep, voffB);
        PG8_WAIT_V(6); PG8_BAR;
    }
    for (;;) {
        const bool has_next = S.next(ui + 1, nxt);
        const char* nA = has_next ? (const char*)g.A + (size_t)nxt.pm * tstep : cA; const char* nB = has_next ? (const char*)g.Bt + (size_t)nxt.pn * tstep : cB;
        for (int t = 0; t < nt; t += 2) {
            const bool last = (t == nt - 2);
            const char* a1 = cA + (size_t)(t + 1) * kstep;
            const char* a2 = last ? nA : cA + (size_t)(t + 2) * kstep; const char* b2 = last ? nB : cB + (size_t)(t + 2) * kstep;
            const char* a3 = a2 + kstep; const char* b3 = b2 + kstep;
            if (last && has_next) S.a_ready(nxt);
            if constexpr (SP2) {
            PG8_LDB(B0, 0, 0); PG8_LDB(B1, 0, 1); PG8_SCHED; PG8_LDA(At, 0, 0); PG8_STAGE(PG8_SA(1, 1), a1 + hstep, voffA);
            PG8_WAIT_V(8); PG8_WAIT_L(0); PG8_BAR; PG8_MMA(0, 0, At, B0); PG8_MMA(0, 1, At, B1); PG8_BAR; PG8_SCHED;
            PG8_LDA(At, 0, 1); PG8_STAGE(PG8_SB(0, 0), b2, voffB); PG8_STAGE(PG8_SB(0, 1), b2 + hstep, voffB); PG8_STAGE(PG8_SA(0, 0), a2, voffA);
            PG8_WAIT_V(8); PG8_WAIT_L(0); PG8_BAR; PG8_MMA(1, 0, At, B0); PG8_MMA(1, 1, At, B1); PG8_BAR; PG8_SCHED;
            PG8_LDB(B0, 1, 0); PG8_LDB(B1, 1, 1); PG8_SCHED; PG8_LDA(At, 1, 0); PG8_STAGE(PG8_SA(0, 1), a2 + hstep, voffA);
            PG8_WAIT_V(8); PG8_WAIT_L(0); PG8_BAR; PG8_MMA(0, 0, At, B0); PG8_MMA(0, 1, At, B1); PG8_BAR; PG8_SCHED;
            PG8_LDA(At, 1, 1); PG8_STAGE(PG8_SB(1, 0), b3, voffB); PG8_STAGE(PG8_SB(1, 1), b3 + hstep, voffB); PG8_STAGE(PG8_SA(1, 0), a3, voffA);
            PG8_WAIT_V(8); PG8_WAIT_L(0); PG8_BAR; PG8_MMA(1, 0, At, B0); PG8_MMA(1, 1, At, B1); PG8_BAR; PG8_SCHED;
            } else {
            PG8_LDB(B0, 0, 0); PG8_SCHED; PG8_LDA(At, 0, 0); PG8_STAGE(PG8_SA(1, 1), a1 + hstep, voffA);
            PG8_WAIT_L(8); PG8_BAR; PG8_WAIT_L(0); PG8_MMA(0, 0, At, B0); PG8_BAR; PG8_SCHED;
            PG8_LDB(B1, 0, 1); PG8_STAGE(PG8_SB(0, 0), b2, voffB);
            PG8_BAR; PG8_WAIT_L(0); PG8_MMA(0, 1, At, B1); PG8_BAR;
            PG8_LDA(At, 0, 1); PG8_STAGE(PG8_SA(0, 0), a2, voffA);
            PG8_BAR; PG8_WAIT_L(0); PG8_MMA(1, 0, At, B0); PG8_BAR; PG8_SCHED;
            PG8_STAGE(PG8_SB(0, 1), b2 + hstep, voffB);
            PG8_WAIT_V(6); PG8_BAR; PG8_MMA(1, 1, At, B1); PG8_BAR;
            PG8_LDB(B0, 1, 0); PG8_SCHED; PG8_LDA(At, 1, 0); PG8_STAGE(PG8_SA(0, 1), a2 + hstep, voffA);
            PG8_WAIT_L(8); PG8_BAR; PG8_WAIT_L(0); PG8_MMA(0, 0, At, B0); PG8_BAR; PG8_SCHED;
            PG8_LDB(B1, 1, 1); PG8_STAGE(PG8_SB(1, 0), b3, voffB);
            PG8_BAR; PG8_WAIT_L(0); PG8_MMA(0, 1, At, B1); PG8_BAR;
            PG8_LDA(At, 1, 1); PG8_STAGE(PG8_SA(1, 0), a3, voffA);
            PG8_BAR; PG8_WAIT_L(0); PG8_MMA(1, 0, At, B0); PG8_BAR; PG8_SCHED;
            PG8_STAGE(PG8_SB(1, 1), b3 + hstep, voffB);
            PG8_WAIT_V(6); PG8_BAR; PG8_MMA(1, 1, At, B1); PG8_BAR;
            }
        }
        if constexpr (ALIGN_EPI) { if (wr == 0) PG8_BAR; }
        if constexpr (!Epi::AFTER_DRAIN) { E(acc, cur, wr, wc, fr, fq); S.done(cur); }
        if (!has_next) break;
#pragma unroll
        for (int a = 0; a < 2; ++a)
#pragma unroll
            for (int b = 0; b < 2; ++b)
#pragma unroll
                for (int m = 0; m < 4; ++m)
#pragma unroll
                    for (int n = 0; n < 2; ++n) acc[a][b][m][n] = (f32x4){0.f, 0.f, 0.f, 0.f};
        cur = nxt; cA = nA; cB = nB; ++ui;
        if constexpr (ALIGN_EPI) { if (wr == 1) PG8_BAR; }
    }
    PG8_WAIT_V(0);
    if constexpr (!ALIGN_EPI) { if (wr == 0) PG8_BAR; }
    PG8_BAR;
    if constexpr (Epi::AFTER_DRAIN) { E.fused(acc, cur, wr, wc, fr, fq, lds, wid, lane); S.done(cur); }
#undef PG8_SA
#undef PG8_SB
#undef PG8_STAGE
#undef PG8_LDA
#undef PG8_LDB
#undef PG8_MMA
#undef PG8_WAIT_V
#undef PG8_WAIT_L
#undef PG8_BAR
#undef PG8_SCHED
}
}

struct Args {
    const float* in[19]; float* out; unsigned char* ws; int ph_lo, ph_hi;
};
struct Frame {
    const float *x_prompt, *x_sample, *cache_k, *cache_v, *st_f, *st_b, *c, *c_ctx, *norm_gain, *w_mod, *b_mod, *w_in, *w_alpha, *b_alpha, *dlam, *gla_gain, *diff_gain, *w_out, *final_gain;
    float* out; unsigned char* ws;
    float *MOD, *H, *P, *OGF, *OGB, *OD, *MG;
    float *ROPE, *LR;
    unsigned short *WINT, *WOT, *HB, *QG, *KG, *VG, *DQ, *DKP, *DVP, *DKS, *DVS, *SG, *MGB, *VGT;
    unsigned char* GSC;
    int tid, lane, wave, G, bid;
};
__device__ __forceinline__ float wave_sum(float v) {
#pragma unroll
    for (int o = 32; o > 0; o >>= 1) v += __shfl_xor(v, o);
    return v;
}
__device__ __forceinline__ float wave_max(float v) {
#pragma unroll
    for (int o = 32; o > 0; o >>= 1) v = fmaxf(v, __shfl_xor(v, o));
    return v;
}
__device__ __forceinline__ float silu_f(float x) { return x / (1.0f + expf(-x)); }
__device__ __forceinline__ const float* xrow(const Frame& F, int r) { return r < NPR ? F.x_prompt + (size_t)r * D : F.x_sample + (size_t)(r - NPR) * D; }
__device__ __forceinline__ int variant_of(int r) { return r < NPR ? 0 : 1 + (r - NPR) / 1024; }
__device__ __forceinline__ float lam_value(const Frame& F) {
    float a = 0.f, b = 0.f;
    for (int i = 0; i < 64; ++i) { a += F.dlam[i] * F.dlam[64 + i]; b += F.dlam[128 + i] * F.dlam[192 + i]; }
    return expf(a) - expf(b) + 0.2f;
}

__device__ void ph_mod(const Frame& F) {
    for (int e = F.bid * NTHR + F.tid; e < 3072; e += F.G * NTHR) {
        float a0 = 0.f, a1 = 0.f, a2 = 0.f;
        for (int d = 0; d < D; ++d) {
            const float w = F.w_mod[(size_t)d * 3072 + e];
            a0 += silu_f(F.c_ctx[d]) * w; a1 += silu_f(F.c[d]) * w; a2 += silu_f(F.c[D + d]) * w;
        }
        const float bb = F.b_mod[e];
        F.MOD[e] = a0 + bb; F.MOD[3072 + e] = a1 + bb; F.MOD[6144 + e] = a2 + bb;
    }
}
__device__ void ph_h(const Frame& F) {
    for (int r = F.bid * 8 + F.wave; r < NT; r += F.G * 8) {
        const float* x = xrow(F, r); const float* m = F.MOD + variant_of(r) * 3072;
        float4 v[4]; float ss = 0.f;
#pragma unroll
        for (int i = 0; i < 4; ++i) { v[i] = *(const float4*)(x + i * 256 + F.lane * 4); ss += v[i].x * v[i].x + v[i].y * v[i].y + v[i].z * v[i].z + v[i].w * v[i].w; }
        ss = wave_sum(ss);
        const float rstd = 1.0f / sqrtf(ss * (1.0f / 1024.0f) + 1e-6f);
#pragma unroll
        for (int i = 0; i < 4; ++i) {
            const int k = i * 256 + F.lane * 4;
            const float4 g = *(const float4*)(F.norm_gain + k), sh = *(const float4*)(m + k), sc = *(const float4*)(m + 1024 + k);
            float4 o;
            o.x = v[i].x * rstd * g.x * (1.0f + sc.x) + sh.x; o.y = v[i].y * rstd * g.y * (1.0f + sc.y) + sh.y;
            o.z = v[i].z * rstd * g.z * (1.0f + sc.z) + sh.z; o.w = v[i].w * rstd * g.w * (1.0f + sc.w) + sh.w;
            *(float4*)(F.H + (size_t)r * D + k) = o;
        }
    }
}
template <class Epi>
__device__ void gemm_naive(const Frame& F, LAS float* lds, const float* A, int lda, const float* B, int ldb, int M, int N, int K, const Epi& E) {
    LAS float* As = lds;
    LAS float* Bs = lds + 16 * 132;
    const int ntn = (N + 63) / 64, ntm = M / 128, nt = ntn * ntm;
    const int tid = F.tid, ty = tid >> 4, tx = tid & 15;
    for (int t = F.bid; t < nt; t += F.G) {
        const int tm = t / ntn, tn = t % ntn, row0 = tm * 128, col0 = tn * 64;
        float acc[4][4];
#pragma unroll
        for (int i = 0; i < 4; ++i)
#pragma unroll
            for (int j = 0; j < 4; ++j) acc[i][j] = 0.f;
        for (int k0 = 0; k0 < K; k0 += 16) {
            { const int r = tid >> 2, kq = (tid & 3) * 4; const float4 a = *(const float4*)(A + (size_t)(row0 + r) * lda + k0 + kq);
              As[(kq + 0) * 132 + r] = a.x; As[(kq + 1) * 132 + r] = a.y; As[(kq + 2) * 132 + r] = a.z; As[(kq + 3) * 132 + r] = a.w; }
            { const int k = tid >> 5, c = (tid & 31) * 2; float2 b = make_float2(0.f, 0.f); if (col0 + c < N) b = *(const float2*)(B + (size_t)(k0 + k) * ldb + col0 + c);
              Bs[k * 64 + c] = b.x; Bs[k * 64 + c + 1] = b.y; }
            __syncthreads();
#pragma unroll
            for (int kk = 0; kk < 16; ++kk) {
                float a[4], b[4];
#pragma unroll
                for (int i = 0; i < 4; ++i) { a[i] = As[kk * 132 + ty * 4 + i]; b[i] = Bs[kk * 64 + tx * 4 + i]; }
#pragma unroll
                for (int i = 0; i < 4; ++i)
#pragma unroll
                    for (int j = 0; j < 4; ++j) acc[i][j] += a[i] * b[j];
            }
            __syncthreads();
        }
#pragma unroll
        for (int i = 0; i < 4; ++i)
#pragma unroll
            for (int j = 0; j < 4; ++j) { const int r = row0 + ty * 4 + i, c = col0 + tx * 4 + j; if (c < N) E(r, c, acc[i][j]); }
    }
}
struct EpiIn { float* P; float* out;
    __device__ __forceinline__ void operator()(int r, int c, float v) const {
        P[(size_t)r * PW + c] = v;
        if (r < NPR) { if (c >= C_DK && c < C_DV) out[O_NK + (size_t)r * 512 + (c - C_DK)] = v; else if (c >= C_DV && c < C_GATE) out[O_NV + (size_t)r * 512 + (c - C_DV)] = v; }
    } };
struct EpiOut { const Frame* F;
    __device__ __forceinline__ void operator()(int r, int c, float v) const {
        const float gt = F->MOD[variant_of(r) * 3072 + 2048 + c];
        F->out[(size_t)r * D + c] = xrow(*F, r)[c] + gt * v;
    } };
__device__ void ph_rope(const Frame& F) {
    const long total = (long)NSR * 512;
    for (long idx = (long)F.bid * NTHR + F.tid; idx < total; idx += (long)F.G * NTHR) {
        const int p = (int)(idx & 31), vec = (int)((idx >> 5) & 7), which = (int)((idx >> 8) & 1), rs = (int)(idx >> 9);
        const int t = rs & 1023, gr = t >> 6, gc = t & 63;
        const int i = p & 15; const int pos = p < 16 ? gr : gc; const int d1 = (p < 16 ? 0 : 32) + i, d2 = d1 + 16;
        const float inv = powf(10000.0f, -(float)i / 16.0f);
        const float ang = (float)pos * inv, cs = cosf(ang), sn = sinf(ang);
        float* base = F.P + (size_t)(NPR + rs) * PW + (which ? C_DK : C_DQ) + vec * 64;
        const float v1 = base[d1], v2 = base[d2];
        base[d1] = v1 * cs - v2 * sn; base[d2] = v1 * sn + v2 * cs;
    }
}
__device__ __forceinline__ float log_sigmoid_f(float z) { return fminf(z, 0.f) - log1pf(expf(-fabsf(z))); }
__device__ void ph_gla(const Frame& F, LAS float* lds) {
    LAS float* al = lds;
    LAS float* qs = al + 4096;
    LAS float* ks = qs + 4096;
    LAS float* vs = ks + 4096;
    LAS float* po = vs + 8192;
    const int tid = F.tid, j = tid & 127, kq = tid >> 7;
    for (int item = F.bid; item < 144; item += F.G) {
        int grp, b, h, dir;
        if (item < 128) { grp = 0; b = item >> 3; h = (item >> 1) & 3; dir = item & 1; } else { const int it = item - 128; grp = 1; b = it >> 3; h = (it >> 1) & 3; dir = it & 1; }
        const int R0 = grp == 0 ? b * 256 : NPR + b * 1024, n = grp == 0 ? 256 : 1024;
        float S[16];
        if (grp == 0) {
#pragma unroll
            for (int i = 0; i < 16; ++i) S[i] = 0.f;
        } else {
            const float* st = (dir == 0 ? F.st_f : F.st_b) + (size_t)(b * 4 + h) * 64 * 128;
#pragma unroll
            for (int i = 0; i < 16; ++i) S[i] = st[(kq * 16 + i) * 128 + j];
        }
        float* OG = dir == 0 ? F.OGF : F.OGB;
        for (int c0 = 0; c0 < n; c0 += 64) {
            __syncthreads();
            for (int e = tid; e < 4096; e += NTHR) {
                const int s = e >> 6, k = e & 63; const int t = dir == 0 ? c0 + s : n - 1 - (c0 + s); const float* prow = F.P + (size_t)(R0 + t) * PW;
                float z = F.b_alpha[dir * 256 + h * 64 + k];
                for (int r = 0; r < 16; ++r) z += prow[(dir == 0 ? C_LRF : C_LRB) + r] * F.w_alpha[(size_t)(dir * 16 + r) * 256 + h * 64 + k];
                al[e] = expf(log_sigmoid_f(z) * (1.0f / 16.0f));
                qs[e] = prow[C_GQ + h * 64 + k] * 0.125f;
                ks[e] = prow[C_GK + h * 64 + k];
            }
            for (int e = tid; e < 8192; e += NTHR) {
                const int s = e >> 7, jj = e & 127; const int t = dir == 0 ? c0 + s : n - 1 - (c0 + s);
                vs[e] = F.P[(size_t)(R0 + t) * PW + C_GV + h * 128 + jj];
            }
            __syncthreads();
            for (int s = 0; s < 64; ++s) {
                const float v = vs[s * 128 + j]; float o = 0.f;
#pragma unroll
                for (int i = 0; i < 16; ++i) { const int k = kq * 16 + i; S[i] = al[s * 64 + k] * S[i] + ks[s * 64 + k] * v; o += qs[s * 64 + k] * S[i]; }
                po[((s & 1) * 4 + kq) * 128 + j] = o;
                __syncthreads();
                if (kq == 0) {
                    const int t = dir == 0 ? c0 + s : n - 1 - (c0 + s);
                    const int pb = (s & 1) * 4;
                    OG[(size_t)(R0 + t) * 512 + h * 128 + j] = po[(pb + 0) * 128 + j] + po[(pb + 1) * 128 + j] + po[(pb + 2) * 128 + j] + po[(pb + 3) * 128 + j];
                }
            }
        }
        if (grp == 0) {
            float* so = F.out + (dir == 0 ? O_SF : O_SB) + (size_t)(b * 4 + h) * 64 * 128;
#pragma unroll
            for (int i = 0; i < 16; ++i) so[(kq * 16 + i) * 128 + j] = S[i];
        }
    }
}
__device__ void ph_diff(const Frame& F, LAS float* lds) {
    LAS float* wl = lds + F.wave * 3328;
    LAS float* qb = wl; LAS float* s1 = wl + 128; LAS float* s2 = s1 + 1536;
    const float lam = lam_value(F);
    const int lane = F.lane;
    for (int item = F.bid * 8 + F.wave; item < NT * 4; item += F.G * 8) {
        const int r = item >> 2, h = item & 3;
        int R0, nc, nk, b;
        if (r < NPR) { b = r >> 8; R0 = b * 256; nc = 0; nk = 256; } else { b = (r - NPR) >> 10; R0 = NPR + b * 1024; nc = 512; nk = 1536; }
        const float* qp = F.P + (size_t)r * PW + C_DQ + h * 128;
        qb[lane] = qp[lane]; qb[64 + lane] = qp[64 + lane];
        __builtin_amdgcn_wave_barrier();
        float m1 = -3.0e38f, m2 = -3.0e38f;
        for (int jk = lane; jk < nk; jk += 64) {
            const float* kp = jk < nc ? F.cache_k + ((size_t)(b * 512 + jk) * 4 + h) * 128 : F.P + (size_t)(R0 + jk - nc) * PW + C_DK + h * 128;
            float a1 = 0.f, a2 = 0.f;
            for (int d = 0; d < 64; d += 4) {
                const float4 k1 = *(const float4*)(kp + d), k2 = *(const float4*)(kp + 64 + d);
                a1 += qb[d] * k1.x + qb[d + 1] * k1.y + qb[d + 2] * k1.z + qb[d + 3] * k1.w;
                a2 += qb[64 + d] * k2.x + qb[64 + d + 1] * k2.y + qb[64 + d + 2] * k2.z + qb[64 + d + 3] * k2.w;
            }
            a1 *= 0.125f; a2 *= 0.125f; s1[jk] = a1; s2[jk] = a2; m1 = fmaxf(m1, a1); m2 = fmaxf(m2, a2);
        }
        m1 = wave_max(m1); m2 = wave_max(m2);
        float l1 = 0.f, l2 = 0.f;
        for (int jk = lane; jk < nk; jk += 64) { const float e1 = expf(s1[jk] - m1), e2 = expf(s2[jk] - m2); s1[jk] = e1; s2[jk] = e2; l1 += e1; l2 += e2; }
        l1 = wave_sum(l1); l2 = wave_sum(l2);
        const float i1 = 1.0f / l1, i2 = lam / l2;
        for (int jk = lane; jk < nk; jk += 64) s1[jk] = s1[jk] * i1 - s2[jk] * i2;
        __builtin_amdgcn_wave_barrier();
        float2 acc = make_float2(0.f, 0.f);
        for (int jk = 0; jk < nk; ++jk) {
            const float* vp = jk < nc ? F.cache_v + ((size_t)(b * 512 + jk) * 4 + h) * 128 : F.P + (size_t)(R0 + jk - nc) * PW + C_DV + h * 128;
            const float a = s1[jk]; const float2 v = *(const float2*)(vp + lane * 2);
            acc.x += a * v.x; acc.y += a * v.y;
        }
        *(float2*)(F.OD + (size_t)r * 512 + h * 128 + lane * 2) = acc;
        __builtin_amdgcn_wave_barrier();
    }
}

typedef unsigned short bf16_t;
typedef float f32x4 __attribute__((ext_vector_type(4)));
__device__ __forceinline__ unsigned f2bf(float f) { unsigned u = __builtin_bit_cast(unsigned, f); return (u + 0x7fffu + ((u >> 16) & 1u)) >> 16; }
__device__ __forceinline__ unsigned pk2(float lo, float hi) { return f2bf(lo) | (f2bf(hi) << 16); }
__device__ __forceinline__ void st_bf16x4(bf16_t* p, f32x4 v) { uint2 w; w.x = pg8::cvt_pk_bf16(v[0], v[1]); w.y = pg8::cvt_pk_bf16(v[2], v[3]); *(uint2*)p = w; }
__device__ __forceinline__ int orig_col(int n) { return n < 1024 ? n : (n < 3584 ? n + 32 : (n < 3616 ? n - 3584 + 1024 : -1)); }

__device__ __forceinline__ void ph_prep(const Frame& F, LAS unsigned char* lds, bool do_mod) {
    const int tid = F.tid, lane = F.lane, wave = F.wave;
    if (do_mod) {
        LAS float* red = (LAS float*)lds;
        for (int item = F.bid; item < 256; item += F.G) {
            const int cg = item & 7, kg = item >> 3, k0 = kg * 32 + wave * 4;
            float acc[3][3][2];
#pragma unroll
            for (int v = 0; v < 3; ++v)
#pragma unroll
                for (int i = 0; i < 3; ++i) { acc[v][i][0] = 0.f; acc[v][i][1] = 0.f; }
#pragma unroll
            for (int kk = 0; kk < 4; ++kk) {
                const int k = k0 + kk;
                const float s0 = silu_f(F.c_ctx[k]), s1 = silu_f(F.c[k]), s2 = silu_f(F.c[D + k]);
#pragma unroll
                for (int i = 0; i < 3; ++i) {
                    const float2 w = *(const float2*)(F.w_mod + (size_t)k * 3072 + cg * 384 + i * 128 + lane * 2);
                    acc[0][i][0] += s0 * w.x; acc[0][i][1] += s0 * w.y; acc[1][i][0] += s1 * w.x; acc[1][i][1] += s1 * w.y; acc[2][i][0] += s2 * w.x; acc[2][i][1] += s2 * w.y;
                }
            }
#pragma unroll
            for (int v = 0; v < 3; ++v)
#pragma unroll
                for (int i = 0; i < 3; ++i) { red[(wave * 3 + v) * 384 + i * 128 + lane * 2] = acc[v][i][0]; red[(wave * 3 + v) * 384 + i * 128 + lane * 2 + 1] = acc[v][i][1]; }
            __syncthreads();
            for (int e = tid; e < 1152; e += NTHR) {
                const int v = e / 384, col = e - v * 384; float s = 0.f;
#pragma unroll
                for (int w = 0; w < 8; ++w) s += red[(w * 3 + v) * 384 + col];
                if (kg == 0) s += F.b_mod[cg * 384 + col];
                atomicAdd(&F.MOD[v * 3072 + cg * 384 + col], s);
            }
            __syncthreads();
        }
    }
    {
        LAS unsigned short* T = (LAS unsigned short*)lds;
        for (int t = F.bid; t < 1216; t += F.G) {
            const bool isin = t < 960; const int tt = isin ? t : t - 960; const int n0 = (tt >> 4) * 64, k0 = (tt & 15) * 64;
            const float* W = isin ? F.w_in : F.w_out; const int ldw = isin ? PW : D;
            {
                const int k = tid >> 3, n8 = (tid & 7) * 8; const int oc = isin ? orig_col(n0 + n8) : n0 + n8;
                float4 a = make_float4(0.f, 0.f, 0.f, 0.f), b = a;
                if (oc >= 0) { const float* p = W + (size_t)(k0 + k) * ldw + oc; a = *(const float4*)p; b = *(const float4*)(p + 4); }
                T[(n8 + 0) * 66 + k] = (unsigned short)f2bf(a.x); T[(n8 + 1) * 66 + k] = (unsigned short)f2bf(a.y); T[(n8 + 2) * 66 + k] = (unsigned short)f2bf(a.z); T[(n8 + 3) * 66 + k] = (unsigned short)f2bf(a.w);
                T[(n8 + 4) * 66 + k] = (unsigned short)f2bf(b.x); T[(n8 + 5) * 66 + k] = (unsigned short)f2bf(b.y); T[(n8 + 6) * 66 + k] = (unsigned short)f2bf(b.z); T[(n8 + 7) * 66 + k] = (unsigned short)f2bf(b.w);
            }
            __syncthreads();
            {
                const int n = tid >> 3, k8 = (tid & 7) * 8; const LAS unsigned* rp = (const LAS unsigned*)(T + n * 66 + k8);
                uint4 w; w.x = rp[0]; w.y = rp[1]; w.z = rp[2]; w.w = rp[3];
                bf16_t* dst = (isin ? F.WINT : F.WOT) + (size_t)(n0 + n) * D + k0 + k8;
                *(uint4*)dst = w;
            }
            __syncthreads();
        }
    }
    {
        for (int e8 = F.bid * NTHR + tid; e8 < 2 * 65536; e8 += F.G * NTHR) {
            const bool isv = e8 >= 65536; const int g = isv ? e8 - 65536 : e8; const int e = g * 8;
            const int b = e >> 18, rem = e & 262143, j = rem >> 9, c = rem & 511;
            const float* src = (isv ? F.cache_v : F.cache_k) + e;
            const float4 a = *(const float4*)src, bb = *(const float4*)(src + 4);
            uint4 w; w.x = pk2(a.x, a.y); w.y = pk2(a.z, a.w); w.z = pk2(bb.x, bb.y); w.w = pk2(bb.z, bb.w);
            *(uint4*)((isv ? F.DVS : F.DKS) + ((size_t)(b * 1536 + j) * 512 + c)) = w;
        }
    }
    {
        for (int idx = F.bid * NTHR + tid; idx < 1024; idx += F.G * NTHR) {
            const int pos = idx >> 4, i = idx & 15;
            const float ang = (float)pos * powf(10000.0f, -(float)i / 16.0f);
            F.ROPE[idx] = cosf(ang); F.ROPE[1024 + idx] = sinf(ang);
        }
        if (F.bid == 0 && tid < 64) {
            const float a = wave_sum(F.dlam[tid] * F.dlam[64 + tid]), b = wave_sum(F.dlam[128 + tid] * F.dlam[192 + tid]);
            if (tid == 0) F.ROPE[2048] = expf(a) - expf(b) + 0.2f;
        }
    }
}
__device__ __forceinline__ void ph_hb(const Frame& F) {
    for (int r = F.bid * 8 + F.wave; r < NT; r += F.G * 8) {
        const float* x = xrow(F, r); const float* m = F.MOD + variant_of(r) * 3072;
        float4 v[4]; float ss = 0.f;
#pragma unroll
        for (int i = 0; i < 4; ++i) { v[i] = *(const float4*)(x + i * 256 + F.lane * 4); ss += v[i].x * v[i].x + v[i].y * v[i].y + v[i].z * v[i].z + v[i].w * v[i].w; }
        ss = wave_sum(ss);
        const float rstd = 1.0f / sqrtf(ss * (1.0f / 1024.0f) + 1e-6f);
#pragma unroll
        for (int i = 0; i < 4; ++i) {
            const int k = i * 256 + F.lane * 4;
            const float4 g = *(const float4*)(F.norm_gain + k), sh = *(const float4*)(m + k), sc = *(const float4*)(m + 1024 + k);
            uint2 w;
            w.x = pk2(v[i].x * rstd * g.x * (1.0f + sc.x) + sh.x, v[i].y * rstd * g.y * (1.0f + sc.y) + sh.y);
            w.y = pk2(v[i].z * rstd * g.z * (1.0f + sc.z) + sh.z, v[i].w * rstd * g.w * (1.0f + sc.w) + sh.w);
            *(uint2*)(F.HB + (size_t)r * D + k) = w;
        }
    }
}
constexpr float QSCALE_DIFF = 0.125f * 1.4426950408889634f;
struct EpiInFast {
    static constexpr bool PERM = false, AFTER_DRAIN = false;
    bf16_t *QG, *KG, *VGT, *DQ, *DKP, *DVP, *DKS, *DVS, *SG; float* LR; float* out; const float* ROPE; float* P;
    __device__ __forceinline__ void operator()(const f32x4 (&acc)[2][2][4][2], const pg8::Unit& u, int wr, int wc, int fr, int fq) const {
        const int pn = u.pn; const bool samp = u.pm >= 16;
#pragma unroll
        for (int ai = 0; ai < 2; ++ai)
#pragma unroll
            for (int m = 0; m < 4; ++m) {
                const int row = u.pm * 256 + ai * 128 + wr * 64 + m * 16 + fr;
                const int ts = (row - NPR) & 1023, bs = (row - NPR) >> 10;
#pragma unroll
                for (int bj = 0; bj < 2; ++bj) {
                    f32x4 v0 = acc[ai][bj][m][0], v1 = acc[ai][bj][m][1];
                    const int cl = bj * 128 + wc * 32 + fq * 4;
                    if (pn == 0) { st_bf16x4(QG + (size_t)row * 256 + cl, v0 * 0.125f); st_bf16x4(QG + (size_t)row * 256 + cl + 16, v1 * 0.125f); }
                    else if (pn == 1) { st_bf16x4(KG + (size_t)row * 256 + cl, v0); st_bf16x4(KG + (size_t)row * 256 + cl + 16, v1); }
                    else if (pn < 4) {
                        bf16_t* d = VGT + (size_t)((pn - 2) * 256 + cl) * NT + row;
#pragma unroll
                        for (int e = 0; e < 4; ++e) { d[(size_t)e * NT] = (bf16_t)f2bf(v0[e]); d[(size_t)(16 + e) * NT] = (bf16_t)f2bf(v1[e]); }
                    }
                    else if (pn < 8) {
                        const bool isk = pn >= 6; const int c512 = (pn - (isk ? 6 : 4)) * 256 + cl;
                        if (samp) {
                            const int pos = (wc & 1) ? (ts & 63) : (ts >> 6);
                            const f32x4 cs = *(const f32x4*)(ROPE + pos * 16 + fq * 4), sn = *(const f32x4*)(ROPE + 1024 + pos * 16 + fq * 4);
                            const f32x4 r0 = v0 * cs - v1 * sn, r1 = v0 * sn + v1 * cs; v0 = r0; v1 = r1;
                        }
                        if (!isk) { bf16_t* d = DQ + (size_t)row * 512 + c512; st_bf16x4(d, v0 * QSCALE_DIFF); st_bf16x4(d + 16, v1 * QSCALE_DIFF); }
                        else if (!samp) { float* o = out + O_NK + (size_t)row * 512 + c512; *(f32x4*)o = v0; *(f32x4*)(o + 16) = v1; bf16_t* d = DKP + (size_t)row * 512 + c512; st_bf16x4(d, v0); st_bf16x4(d + 16, v1); }
                        else { bf16_t* d = DKS + ((size_t)(bs * 1536 + 512 + ts)) * 512 + c512; st_bf16x4(d, v0); st_bf16x4(d + 16, v1); }
                    }
                    else if (pn < 10) {
                        const int c512 = (pn - 8) * 256 + cl;
                        if (!samp) { float* o = out + O_NV + (size_t)row * 512 + c512; *(f32x4*)o = v0; *(f32x4*)(o + 16) = v1; bf16_t* d = DVP + (size_t)row * 512 + c512; st_bf16x4(d, v0); st_bf16x4(d + 16, v1); }
                        else { bf16_t* d = DVS + ((size_t)(bs * 1536 + 512 + ts)) * 512 + c512; st_bf16x4(d, v0); st_bf16x4(d + 16, v1); }
                    }
                    else if (pn < 14) {
                        bf16_t* d = SG + (size_t)row * 1024 + (pn - 10) * 256 + cl;
                        f32x4 s0, s1;
#pragma unroll
                        for (int j = 0; j < 4; ++j) { s0[j] = v0[j] / (1.0f + __expf(-v0[j])); s1[j] = v1[j] / (1.0f + __expf(-v1[j])); }
                        st_bf16x4(d, s0); st_bf16x4(d + 16, s1);
                    }
                    else { if (bj == 0 && wc == 0) { float* o = LR + (size_t)row * 32 + fq * 4; *(f32x4*)o = v0; *(f32x4*)(o + 16) = v1; } }
                    if (P) {
                        const int n0 = pn * 256 + cl; const int oc = orig_col(n0);
                        if (oc >= 0) { *(f32x4*)(P + (size_t)row * PW + oc) = v0; *(f32x4*)(P + (size_t)row * PW + oc + 16) = v1; }
                    }
                }
            }
    }
};


struct EpiOutFast {
    static constexpr bool PERM = false, AFTER_DRAIN = false;
    const float* x_prompt; const float* x_sample; const float* MOD; float* out;
    __device__ __forceinline__ void operator()(const f32x4 (&acc)[2][2][4][2], const pg8::Unit& u, int wr, int wc, int fr, int fq) const {
        const float* gt = MOD + (u.pm < 16 ? 0 : (u.pm < 20 ? 1 : 2)) * 3072 + 2048;
#pragma unroll
        for (int ai = 0; ai < 2; ++ai)
#pragma unroll
            for (int m = 0; m < 4; ++m) {
                const int row = u.pm * 256 + ai * 128 + wr * 64 + m * 16 + fr;
                const float* xr = row < NPR ? x_prompt + (size_t)row * D : x_sample + (size_t)(row - NPR) * D;
#pragma unroll
                for (int bj = 0; bj < 2; ++bj)
#pragma unroll
                    for (int n = 0; n < 2; ++n) {
                        const int col = u.pn * 256 + bj * 128 + wc * 32 + n * 16 + fq * 4;
                        const f32x4 xv = *(const f32x4*)(xr + col), g4 = *(const f32x4*)(gt + col);
                        *(f32x4*)(out + (size_t)row * D + col) = xv + g4 * acc[ai][bj][m][n];
                    }
            }
    }
};


typedef short bf16x8 __attribute__((ext_vector_type(8)));
typedef short s16x4 __attribute__((ext_vector_type(4)));
typedef __bf16 bf16x8_t __attribute__((ext_vector_type(8)));
typedef float f32x8 __attribute__((ext_vector_type(8)));
typedef float f32x16 __attribute__((ext_vector_type(16)));
typedef unsigned u32x4 __attribute__((ext_vector_type(4)));
typedef unsigned u32x2 __attribute__((ext_vector_type(2)));
#define MFMA32(a, b, c) __builtin_amdgcn_mfma_f32_32x32x16_bf16((a), (b), (c), 0, 0, 0)
__device__ __forceinline__ bf16x8 pack8(f32x8 v) { return __builtin_bit_cast(bf16x8, __builtin_convertvector(v, bf16x8_t)); }
__device__ __forceinline__ float bf2f(unsigned short u) { return __builtin_bit_cast(float, (unsigned)u << 16); }
__device__ __forceinline__ bf16x8 tr8(const LAS unsigned char* p0, const LAS unsigned char* p1) {
    const s16x4 lo = __builtin_amdgcn_ds_read_tr16_b64_v4i16((LAS s16x4*)p0), hi = __builtin_amdgcn_ds_read_tr16_b64_v4i16((LAS s16x4*)p1);
    return __builtin_shufflevector(lo, hi, 0, 1, 2, 3, 4, 5, 6, 7);
}
constexpr int AT_KROW = 272, AT_VROW = 320, AT_KBYTES = 64 * AT_KROW, AT_STAGE = AT_KBYTES + 64 * AT_VROW;
constexpr int AT_EXROW = 129;

template <int VAR>
__device__ __forceinline__ void attn_item(const Frame& F, LAS unsigned char* lds, int grp, int b, int h, int qblk, float lam) {
    int tid = F.tid; asm volatile("" : "+v"(tid));
    const int lane = tid & 63, wave = __builtin_amdgcn_readfirstlane(tid >> 6), rg = wave & 3, map = wave >> 2, r = lane & 31, hh = lane >> 5;
    const int R0 = grp == 0 ? b * 256 : NPR + b * 1024, nk = grp == 0 ? 256 : 1536;
    const size_t kvoff = (size_t)(b * nk) * 512 + h * 128;
    const bf16_t* Kb = (const bf16_t*)(F.ws + (grp == 0 ? WS_DKP : WS_DKS)) + kvoff;
    const bf16_t* Vb = (const bf16_t*)(F.ws + (grp == 0 ? WS_DVP : WS_DVS)) + kvoff;
    const int qrow = R0 + qblk * 128 + rg * 32 + r;
    bf16x8 qf[4];
#pragma unroll
    for (int ks = 0; ks < 4; ++ks) qf[ks] = *(const bf16x8*)(F.DQ + (size_t)qrow * 512 + h * 128 + map * 64 + ks * 16 + hh * 8);
    f32x16 O[4];
#pragma unroll
    for (int jt = 0; jt < 4; ++jt)
#pragma unroll
        for (int i = 0; i < 16; ++i) O[jt][i] = 0.f;
    float m_run = -1.0e30f, l_run = 0.f;
    const int nt = nk >> 6;
    const int srow0 = tid >> 4, sch = tid & 15;
    u32x4 stg[4];
#define AT_LOAD(t) do { _Pragma("unroll") for (int i = 0; i < 2; ++i) { \
        stg[i]     = *(const u32x4*)(Kb + (size_t)((t) * 64 + srow0 + 32 * i) * 512 + sch * 8); \
        stg[2 + i] = *(const u32x4*)(Vb + (size_t)((t) * 64 + srow0 + 32 * i) * 512 + sch * 8); } } while (0)
#define AT_WRITE(buf) do { _Pragma("unroll") for (int i = 0; i < 2; ++i) { \
        *(LAS u32x4*)(lds + (buf) * AT_STAGE + (srow0 + 32 * i) * AT_KROW + sch * 16) = stg[i]; \
        *(LAS u32x4*)(lds + (buf) * AT_STAGE + AT_KBYTES + (srow0 + 32 * i) * AT_VROW + sch * 16) = stg[2 + i]; } } while (0)
    const int koff = r * AT_KROW + map * 128 + hh * 16;
    const int voff = AT_KBYTES + (4 * hh + ((lane & 15) >> 2)) * AT_VROW + (16 * ((lane >> 4) & 1) + 4 * (lane & 3)) * 2;
    AT_LOAD(0); AT_WRITE(0);
    __syncthreads();
    for (int t = 0; t < nt; ++t) {
        const int buf = (VAR & 1) ? 0 : (t & 1);
        if (!(VAR & 1)) { if (t + 1 < nt) AT_LOAD(t + 1); }
        const LAS unsigned char* sb = lds + buf * AT_STAGE;
        f32x16 S[2];
#pragma unroll
        for (int sub = 0; sub < 2; ++sub) {
#pragma unroll
            for (int i = 0; i < 16; ++i) S[sub][i] = 0.f;
#pragma unroll
            for (int ks = 0; ks < 4; ++ks) {
                const bf16x8 kf = *(const LAS bf16x8*)(sb + koff + sub * 32 * AT_KROW + ks * 32);
                if (!(VAR & 8)) S[sub] = MFMA32(kf, qf[ks], S[sub]); else asm volatile("" :: "v"(kf));
            }
        }
        bf16x8 pb[2][2];
        if (!(VAR & 2)) {
        float mx = S[0][0];
#pragma unroll
        for (int i = 1; i < 16; ++i) mx = fmaxf(mx, S[0][i]);
#pragma unroll
        for (int i = 0; i < 16; ++i) mx = fmaxf(mx, S[1][i]);
        mx = fmaxf(mx, __shfl_xor(mx, 32));
        const float m_new = fmaxf(m_run, mx), alpha = __builtin_amdgcn_exp2f(m_run - m_new);
        m_run = m_new; l_run *= alpha;
#pragma unroll
        for (int jt = 0; jt < 4; ++jt) O[jt] = O[jt] * alpha;
#pragma unroll
        for (int sub = 0; sub < 2; ++sub) {
            f32x8 p0, p1;
#pragma unroll
            for (int i = 0; i < 8; ++i) { p0[i] = __builtin_amdgcn_exp2f(S[sub][i] - m_new); p1[i] = __builtin_amdgcn_exp2f(S[sub][8 + i] - m_new); l_run += p0[i] + p1[i]; }
            pb[sub][0] = pack8(p0); pb[sub][1] = pack8(p1);
        }
        } else {
#pragma unroll
            for (int sub = 0; sub < 2; ++sub) { f32x8 p0, p1; _Pragma("unroll") for (int i = 0; i < 8; ++i) { p0[i] = S[sub][i]; p1[i] = S[sub][8 + i]; } pb[sub][0] = pack8(p0); pb[sub][1] = pack8(p1); l_run += S[sub][0]; }
        }
#pragma unroll
        for (int sub = 0; sub < 2; ++sub)
#pragma unroll
            for (int s = 0; s < 2; ++s)
#pragma unroll
                for (int jt = 0; jt < 4; ++jt) {
                    const LAS unsigned char* vp = sb + voff + (32 * sub + 16 * s) * AT_VROW + jt * 64;
                    const bf16x8 vf = tr8(vp, vp + 8 * AT_VROW);
                    if (!(VAR & 4)) O[jt] = MFMA32(vf, pb[sub][s], O[jt]); else asm volatile("" :: "v"(vf), "v"(pb[sub][s]));
                }
        if (!(VAR & 1)) { if (t + 1 < nt) AT_WRITE(buf ^ 1); }
        __syncthreads();
    }
#undef AT_LOAD
#undef AT_WRITE
    const float l_tot = l_run + __shfl_xor(l_run, 32), inv = 1.0f / l_tot;
    LAS float* EX = (LAS float*)lds;
    {
        LAS float* ex = EX + (map * 128 + rg * 32 + r) * AT_EXROW;
#pragma unroll
        for (int jt = 0; jt < 4; ++jt)
#pragma unroll
            for (int i = 0; i < 16; ++i) ex[32 * jt + (i & 3) + 8 * (i >> 2) + 4 * hh] = O[jt][i] * inv;
    }
    __syncthreads();
    {
        const int ql = tid >> 2, part = tid & 3; const int row = R0 + qblk * 128 + ql;
        const LAS float* e0 = EX + ql * AT_EXROW + part * 32; const LAS float* e1 = e0 + 128 * AT_EXROW;
        float o[32]; float ss = 0.f;
#pragma unroll
        for (int j = 0; j < 32; ++j) { o[j] = e0[j] - lam * e1[j]; ss += o[j] * o[j]; }
        ss += __shfl_xor(ss, 1); ss += __shfl_xor(ss, 2);
        const float rstd = 0.8f / sqrtf(ss * (1.0f / 128.0f) + 1e-6f);
        const bf16_t* sg = F.SG + (size_t)row * 1024 + 512 + h * 128 + part * 32;
        bf16_t* dst = F.MGB + (size_t)row * 1024 + 512 + h * 128 + part * 32;
        const float* gain = F.diff_gain + part * 32;
#pragma unroll
        for (int c = 0; c < 4; ++c) {
            const uint4 gw = *(const uint4*)(sg + c * 8); const unsigned gws[4] = {gw.x, gw.y, gw.z, gw.w};
            unsigned w[4];
#pragma unroll
            for (int e = 0; e < 4; ++e) {
                const int j = c * 8 + e * 2;
                const float a0 = o[j] * rstd * gain[j] * bf2f((unsigned short)(gws[e] & 0xffffu)), a1 = o[j + 1] * rstd * gain[j + 1] * bf2f((unsigned short)(gws[e] >> 16));
                w[e] = pk2(a0, a1);
            }
            *(uint4*)(dst + c * 8) = make_uint4(w[0], w[1], w[2], w[3]);
        }
    }
    __syncthreads();
}

constexpr int GU_DS = 0, GU_SC = 32768, GU_QF = 49152, GU_KF = 57344, GU_BL = 65536, GU_BYTES = 67584;
constexpr int GW_R1 = 0, GW_R2 = 9216, GW_BYTES = 14336;
constexpr int GV_ROW = 136, GT_ROW = 80, GO_ROW = 272;
constexpr float LOG2E = 1.4426950408889634f;
typedef short s16x4 __attribute__((ext_vector_type(4)));
__device__ __forceinline__ int crow(int i, int hh) { return (i & 3) + 8 * (i >> 2) + 4 * hh; }
__device__ __forceinline__ f32x16 zero16() { f32x16 z; _Pragma("unroll") for (int i = 0; i < 16; ++i) z[i] = 0.f; return z; }
__device__ __forceinline__ void split8(const float (&x)[8], bf16x8& hi, bf16x8& lo) {
    f32x8 v, w;
#pragma unroll
    for (int i = 0; i < 8; ++i) v[i] = x[i];
    const bf16x8_t h = __builtin_convertvector(v, bf16x8_t);
    const f32x8 hf = __builtin_convertvector(h, f32x8);
#pragma unroll
    for (int i = 0; i < 8; ++i) w[i] = x[i] - hf[i];
    hi = __builtin_bit_cast(bf16x8, h); lo = pack8(w);
}
__device__ __forceinline__ s16x4 rev4(s16x4 v) { return __builtin_shufflevector(v, v, 3, 2, 1, 0); }

struct GSeq { int R0, n, nc, dir, h, b, grp, ubase; };
__device__ __forceinline__ GSeq gseq_decode(int sq) {
    GSeq s;
    if (sq < 16) { s.grp = 1; s.b = sq >> 3; s.h = (sq >> 1) & 3; s.dir = sq & 1; s.R0 = NPR + s.b * 1024; s.n = 1024; s.nc = 16; s.ubase = sq * 16; }
    else { const int p = sq - 16; s.grp = 0; s.b = p >> 3; s.h = (p >> 1) & 3; s.dir = p & 1; s.R0 = s.b * 256; s.n = 256; s.nc = 4; s.ubase = 256 + p * 4; }
    return s;
}
__device__ __forceinline__ int gseq_row(const GSeq& s, int tau) { return s.R0 + (s.dir ? s.n - 1 - tau : tau); }
__device__ __forceinline__ bf16x8 g2_vfrag(const LAS unsigned char* R1, int dir, int jl, int st, int sp, int r, int hh) {
    const LAS unsigned char* row = R1 + (32 * jl + r) * GV_ROW;
    const int base = 32 * st + 16 * sp + 4 * hh;
    s16x4 lo, hi;
    if (dir == 0) { lo = *(const LAS s16x4*)(row + base * 2); hi = *(const LAS s16x4*)(row + (base + 8) * 2); }
    else { lo = rev4(*(const LAS s16x4*)(row + (60 - base) * 2)); hi = rev4(*(const LAS s16x4*)(row + (52 - base) * 2)); }
    return __builtin_shufflevector(lo, hi, 0, 1, 2, 3, 4, 5, 6, 7);
}
__device__ __forceinline__ void g2_load_vt(const Frame& F, LAS unsigned char* R1, int h, int half, int tbase, int lane) {
#pragma unroll
    for (int i = 0; i < 8; ++i) {
        const int jl = 8 * i + (lane >> 3), ch = lane & 7;
        const u32x2* src = (const u32x2*)(F.VGT + (size_t)(h * 128 + 64 * half + jl) * NT + tbase + ch * 8);
        const u32x2 a = src[0], b = src[1];
        *(LAS u32x2*)(R1 + jl * GV_ROW + ch * 16) = a; *(LAS u32x2*)(R1 + jl * GV_ROW + ch * 16 + 8) = b;
    }
}

__device__ __forceinline__ void gla1_unit(const Frame& F, LAS unsigned char* wl, int u, int lane0) {
    int lane = lane0; asm volatile("" : "+v"(lane));
    const GSeq s = gseq_decode(u < 256 ? (u >> 4) : 16 + ((u - 256) >> 2));
    const int c = u < 256 ? (u & 15) : ((u - 256) & 3);
    const int h = s.h, dir = s.dir;
    unsigned char* blk = F.GSC + (size_t)u * GU_BYTES;
    LAS unsigned char* R1 = wl + GW_R1; LAS unsigned char* R2 = wl + GW_R2;
    const int tbase = s.R0 + (dir ? s.n - 64 - 64 * c : 64 * c);
#pragma unroll 1
    for (int kt = 0; kt < 2; ++kt) {
        int ln = lane; asm volatile("" : "+v"(ln));
        const int r = ln & 31, hh = ln >> 5;
        bf16x8 Ltri[2], Lone, Iden[2];
#pragma unroll
        for (int jj = 0; jj < 8; ++jj) Lone[jj] = (short)0x3F80;
#pragma unroll
        for (int sp = 0; sp < 2; ++sp)
#pragma unroll
            for (int jj = 0; jj < 8; ++jj) {
                const int sx = 16 * sp + 8 * (jj >> 2) + 4 * hh + (jj & 3); Ltri[sp][jj] = (sx <= r) ? (short)0x3F80 : (short)0;
                Iden[sp][jj] = (16 * sp + 8 * hh + jj == r) ? (short)0x3F80 : (short)0;
            }
#pragma unroll
        for (int i = 0; i < 4; ++i) {
            const int tl = 16 * i + (ln >> 2), ch = ln & 3;
            *(LAS u32x4*)(R2 + tl * GT_ROW + ch * 16) = *(const u32x4*)(F.KG + (size_t)gseq_row(s, 64 * c + tl) * 256 + h * 64 + 32 * kt + ch * 8);
        }
        bf16x8 whi, wlo;
        {
            float w[8];
#pragma unroll
            for (int jj = 0; jj < 8; ++jj) w[jj] = F.w_alpha[(size_t)(dir * 16 + 8 * hh + jj) * 256 + h * 64 + 32 * kt + r];
            split8(w, whi, wlo);
        }
        const float bias = F.b_alpha[dir * 256 + h * 64 + 32 * kt + r];
        bf16x8 ghi[2][2], glo[2][2];
#pragma unroll
        for (int tt = 0; tt < 2; ++tt) {
            const float* lp = F.LR + (size_t)gseq_row(s, 64 * c + 32 * tt + r) * 32 + dir * 16 + 8 * hh;
            const float4 l0 = *(const float4*)lp, l1 = *(const float4*)(lp + 4);
            const float lx[8] = {l0.x, l0.y, l0.z, l0.w, l1.x, l1.y, l1.z, l1.w};
            bf16x8 ahi, alo; split8(lx, ahi, alo);
            f32x16 z = MFMA32(ahi, whi, zero16()); z = MFMA32(alo, whi, z); z = MFMA32(ahi, wlo, z);
            float gv[16];
#pragma unroll
            for (int i = 0; i < 16; ++i) {
                const float zz = z[i] + bias;
                const float sp = __builtin_amdgcn_logf(1.0f + __builtin_amdgcn_exp2f(-fabsf(zz) * LOG2E)) * 0.6931471805599453f;
                gv[i] = (fminf(zz, 0.f) - sp) * 0.0625f;
            }
#pragma unroll
            for (int sp = 0; sp < 2; ++sp) { float x[8]; _Pragma("unroll") for (int jj = 0; jj < 8; ++jj) x[jj] = gv[8 * sp + jj]; split8(x, ghi[tt][sp], glo[tt][sp]); }
        }
        f32x16 bb[2];
        {
            f32x16 a = zero16(), d = zero16();
#pragma unroll
            for (int sp = 0; sp < 2; ++sp) { a = MFMA32(Ltri[sp], ghi[0][sp], a); a = MFMA32(Ltri[sp], glo[0][sp], a); }
#pragma unroll
            for (int sp = 0; sp < 2; ++sp) { d = MFMA32(Lone, ghi[0][sp], d); d = MFMA32(Lone, glo[0][sp], d); d = MFMA32(Ltri[sp], ghi[1][sp], d); d = MFMA32(Ltri[sp], glo[1][sp], d); }
            bb[0] = a; bb[1] = d;
        }
        float blast;
        { const float x = bb[1][15]; const float y = __shfl_xor(x, 32); blast = hh ? x : y; }
        if (hh == 0) ((float*)(blk + GU_BL))[32 * kt + r] = blast;
        bf16x8 khat[2][2];
#pragma unroll
        for (int st = 0; st < 2; ++st) {
            const LAS unsigned char* kp = R2 + (32 * st + r) * GT_ROW + 8 * hh * 2;
            f32x16 ka = MFMA32(*(const LAS bf16x8*)(kp), Iden[0], zero16()); ka = MFMA32(*(const LAS bf16x8*)(kp + 32), Iden[1], ka);
            float kh[16];
#pragma unroll
            for (int i = 0; i < 16; ++i) {
                const float bv = bb[st][i];
                kh[i] = ka[i] * __builtin_amdgcn_exp2f((blast - bv) * LOG2E);
                *(LAS unsigned short*)(R1 + (32 * st + crow(i, hh)) * GT_ROW + r * 2) = (unsigned short)f2bf(ka[i] * __builtin_amdgcn_exp2f(-bv * LOG2E));
            }
#pragma unroll
            for (int sp = 0; sp < 2; ++sp) { f32x8 x; _Pragma("unroll") for (int jj = 0; jj < 8; ++jj) x[jj] = kh[8 * sp + jj]; khat[st][sp] = pack8(x); }
        }
        {
            bf16_t* KF = (bf16_t*)(blk + GU_KF);
#pragma unroll
            for (int st = 0; st < 2; ++st)
#pragma unroll
                for (int ksl = 0; ksl < 2; ++ksl)
                    *(u32x4*)(KF + ((((st * 4 + 2 * kt + ksl) * 2 + hh) * 32 + r) * 8)) = *(const LAS u32x4*)(R1 + (32 * st + r) * GT_ROW + (16 * ksl + 8 * hh) * 2);
        }
#pragma unroll
        for (int i = 0; i < 4; ++i) {
            const int tl = 16 * i + (ln >> 2), ch = ln & 3;
            *(LAS u32x4*)(R2 + tl * GT_ROW + ch * 16) = *(const u32x4*)(F.QG + (size_t)gseq_row(s, 64 * c + tl) * 256 + h * 64 + 32 * kt + ch * 8);
        }
#pragma unroll
        for (int tt = 0; tt < 2; ++tt) {
            const LAS unsigned char* qp = R2 + (32 * tt + r) * GT_ROW + 8 * hh * 2;
            f32x16 qa = MFMA32(*(const LAS bf16x8*)(qp), Iden[0], zero16()); qa = MFMA32(*(const LAS bf16x8*)(qp + 32), Iden[1], qa);
#pragma unroll
            for (int i = 0; i < 16; ++i)
                *(LAS unsigned short*)(R1 + (32 * tt + crow(i, hh)) * GT_ROW + r * 2) = (unsigned short)f2bf(qa[i] * __builtin_amdgcn_exp2f(bb[tt][i] * LOG2E));
        }
        {
            bf16_t* QF = (bf16_t*)(blk + GU_QF);
#pragma unroll
            for (int tt = 0; tt < 2; ++tt)
#pragma unroll
                for (int ksl = 0; ksl < 2; ++ksl)
                    *(u32x4*)(QF + ((((tt * 4 + 2 * kt + ksl) * 2 + hh) * 32 + r) * 8)) = *(const LAS u32x4*)(R1 + (32 * tt + r) * GT_ROW + (16 * ksl + 8 * hh) * 2);
        }
        float* DS = (float*)(blk + GU_DS);
#pragma unroll 1
        for (int half = 0; half < 2; ++half) {
            g2_load_vt(F, R1, h, half, tbase, ln);
#pragma unroll
            for (int jl = 0; jl < 2; ++jl) {
                f32x16 d0 = zero16();
#pragma unroll
                for (int st = 0; st < 2; ++st)
#pragma unroll
                    for (int sp = 0; sp < 2; ++sp) d0 = MFMA32(g2_vfrag(R1, dir, jl, st, sp, r, hh), khat[st][sp], d0);
                const int jt = 2 * half + jl;
#pragma unroll
                for (int i = 0; i < 16; ++i) DS[((jt * 2 + kt) * 16 + i) * 64 + ln] = d0[i];
            }
        }
    }
}

__device__ __forceinline__ void gla2_scan(const Frame& F, int sq, int tid0) {
    int tid = tid0; asm volatile("" : "+v"(tid));
    const GSeq s = gseq_decode(sq);
    float S[2][8];
#pragma unroll
    for (int q = 0; q < 2; ++q) {
        const int p = tid + 512 * q, j = p >> 3, k8 = (p & 7) * 8;
        if (s.grp == 0) { _Pragma("unroll") for (int e = 0; e < 8; ++e) S[q][e] = 0.f; }
        else { const float* st = (s.dir == 0 ? F.st_f : F.st_b) + (size_t)(s.b * 4 + s.h) * 8192; _Pragma("unroll") for (int e = 0; e < 8; ++e) S[q][e] = st[(k8 + e) * 128 + j]; }
    }
    for (int c = 0; c < s.nc; ++c) {
        unsigned char* blk = F.GSC + (size_t)(s.ubase + c) * GU_BYTES;
        const float* DS = (const float*)(blk + GU_DS); const float* BL = (const float*)(blk + GU_BL); bf16_t* SC = (bf16_t*)(blk + GU_SC);
#pragma unroll
        for (int q = 0; q < 2; ++q) {
            const int p = tid + 512 * q, j = p >> 3, k8 = (p & 7) * 8;
            const int jt = j >> 5, jr = j & 31, ks = k8 >> 4, khh = (k8 >> 3) & 1;
            u32x4 w; w.x = pk2(S[q][0], S[q][1]); w.y = pk2(S[q][2], S[q][3]); w.z = pk2(S[q][4], S[q][5]); w.w = pk2(S[q][6], S[q][7]);
            *(u32x4*)(SC + ((((jt * 4 + ks) * 2 + khh) * 32 + jr) * 8)) = w;
            const int jhh = (jr >> 2) & 1, ji = (jr & 3) + 4 * (jr >> 3), kt = k8 >> 5;
            const float* dp = DS + ((jt * 2 + kt) * 16 + ji) * 64 + jhh * 32 + (k8 & 31);
            const float4 d0 = *(const float4*)dp, d1 = *(const float4*)(dp + 4), b0 = *(const float4*)(BL + k8), b1 = *(const float4*)(BL + k8 + 4);
            const float dd[8] = {d0.x, d0.y, d0.z, d0.w, d1.x, d1.y, d1.z, d1.w}, bl[8] = {b0.x, b0.y, b0.z, b0.w, b1.x, b1.y, b1.z, b1.w};
#pragma unroll
            for (int e = 0; e < 8; ++e) S[q][e] = __builtin_amdgcn_exp2f(bl[e] * LOG2E) * S[q][e] + dd[e];
        }
    }
    if (s.grp == 0) {
        float* so = F.out + (s.dir == 0 ? O_SF : O_SB) + (size_t)(s.b * 4 + s.h) * 8192;
#pragma unroll
        for (int q = 0; q < 2; ++q) { const int p = tid + 512 * q, j = p >> 3, k8 = (p & 7) * 8; _Pragma("unroll") for (int e = 0; e < 8; ++e) so[(k8 + e) * 128 + j] = S[q][e]; }
    }
}

__device__ __forceinline__ void gla3_unit(const Frame& F, LAS unsigned char* wl, int w3, int lane0) {
    int lane = lane0; asm volatile("" : "+v"(lane));
    const int ttn = w3 & 1, cu = w3 >> 1;
    int grp, b, h, c, nc, R0;
    if (cu < 128) { grp = 1; b = cu >> 6; h = (cu >> 4) & 3; c = cu & 15; nc = 16; R0 = NPR + b * 1024; } else { const int cp = cu - 128; grp = 0; b = cp >> 4; h = (cp >> 2) & 3; c = cp & 3; nc = 4; R0 = b * 256; }
    const int sqf = grp ? (b * 4 + h) * 2 : 16 + (b * 4 + h) * 2;
    const int ubf = grp ? sqf * 16 : 256 + (sqf - 16) * 4, ubb = grp ? (sqf + 1) * 16 : 256 + (sqf + 1 - 16) * 4;
    LAS unsigned char* R1 = wl + GW_R1;
    const int r = lane & 31, hh = lane >> 5;
    f32x16 o[4];
#pragma unroll
    for (int jt = 0; jt < 4; ++jt) o[jt] = zero16();
    bf16x8 pa[2][2][2];
#pragma unroll
    for (int d = 0; d < 2; ++d) {
        const unsigned char* blk = F.GSC + (size_t)(d ? ubb + (nc - 1 - c) : ubf + c) * GU_BYTES;
        const bf16_t* QF = (const bf16_t*)(blk + GU_QF); const bf16_t* KF = (const bf16_t*)(blk + GU_KF); const bf16_t* SC = (const bf16_t*)(blk + GU_SC);
        const int ttd = d ? 1 - ttn : ttn, rr = d ? 31 - r : r;
        bf16x8 qf[4];
#pragma unroll
        for (int ks = 0; ks < 4; ++ks) qf[ks] = *(const bf16x8*)(QF + ((((ttd * 4 + ks) * 2 + hh) * 32 + rr) * 8));
#pragma unroll
        for (int jt = 0; jt < 4; ++jt) {
            asm volatile("" ::: "memory");
#pragma unroll
            for (int ks = 0; ks < 4; ++ks) o[jt] = MFMA32(*(const bf16x8*)(SC + ((((jt * 4 + ks) * 2 + hh) * 32 + r) * 8)), qf[ks], o[jt]);
        }
#pragma unroll
        for (int st = 0; st < 2; ++st) {
            f32x16 at = zero16();
            if (st <= ttd) {
#pragma unroll
                for (int ks = 0; ks < 4; ++ks) at = MFMA32(*(const bf16x8*)(KF + ((((st * 4 + ks) * 2 + hh) * 32 + r) * 8)), qf[ks], at);
            }
#pragma unroll
            for (int sp = 0; sp < 2; ++sp) {
                f32x8 x;
#pragma unroll
                for (int jj = 0; jj < 8; ++jj) { const int i = 8 * sp + jj; x[jj] = (st < ttd || crow(i, hh) <= rr) ? at[i] : 0.f; }
                pa[d][st][sp] = pack8(x);
            }
        }
    }
#pragma unroll 1
    for (int half = 0; half < 2; ++half) {
        int ln = lane; asm volatile("" : "+v"(ln));
        const int r2 = ln & 31, hh2 = ln >> 5;
        g2_load_vt(F, R1, h, half, R0 + 64 * c, ln);
#pragma unroll
        for (int d = 0; d < 2; ++d) {
            const int ttd = d ? 1 - ttn : ttn;
#pragma unroll
            for (int st = 0; st < 2; ++st) {
                if (st <= ttd) {
#pragma unroll
                    for (int sp = 0; sp < 2; ++sp)
#pragma unroll
                        for (int jl = 0; jl < 2; ++jl) {
                            const bf16x8 vf = g2_vfrag(R1, d, jl, st, sp, r2, hh2);
                            if (half == 0) o[jl] = MFMA32(vf, pa[d][st][sp], o[jl]); else o[2 + jl] = MFMA32(vf, pa[d][st][sp], o[2 + jl]);
                        }
                }
            }
        }
    }
    float ss = 0.f;
#pragma unroll
    for (int jt = 0; jt < 4; ++jt)
#pragma unroll
        for (int i = 0; i < 16; ++i) ss += o[jt][i] * o[jt][i];
    ss += __shfl_xor(ss, 32);
    const float rstd = 1.0f / sqrtf(ss * (1.0f / 128.0f) + 1e-6f);
#pragma unroll
    for (int jt = 0; jt < 4; ++jt)
#pragma unroll
        for (int q = 0; q < 4; ++q) {
            const int j = 32 * jt + 8 * q + 4 * hh; const float4 gn = *(const float4*)(F.gla_gain + j);
            u32x2 w; w.x = pk2(o[jt][4 * q + 0] * rstd * gn.x, o[jt][4 * q + 1] * rstd * gn.y); w.y = pk2(o[jt][4 * q + 2] * rstd * gn.z, o[jt][4 * q + 3] * rstd * gn.w);
            *(LAS u32x2*)(R1 + r * GO_ROW + j * 2) = w;
        }
    const int row0 = R0 + 64 * c + 32 * ttn;
#pragma unroll
    for (int i = 0; i < 8; ++i) {
        const int rl = 4 * i + (lane >> 4), ch = lane & 15;
        const u32x4 v = *(const LAS u32x4*)(R1 + rl * GO_ROW + ch * 16);
        const u32x4 gw = *(const u32x4*)(F.SG + (size_t)(row0 + rl) * 1024 + h * 128 + ch * 8);
        u32x4 w;
#pragma unroll
        for (int e = 0; e < 4; ++e) w[e] = pk2(bf2f((unsigned short)(v[e] & 0xffffu)) * bf2f((unsigned short)(gw[e] & 0xffffu)), bf2f((unsigned short)(v[e] >> 16)) * bf2f((unsigned short)(gw[e] >> 16)));
        *(u32x4*)(F.MGB + (size_t)(row0 + rl) * 1024 + h * 128 + ch * 8) = w;
    }
}

#ifndef PROBE_MIXSEL
#define PROBE_MIXSEL 0
#endif
template <int AVAR>
__device__ __forceinline__ void ph_mix_a(const Frame& F, LAS unsigned char* lds, int sel) {
    const float lam = __builtin_bit_cast(float, __builtin_amdgcn_readfirstlane(__builtin_bit_cast(int, F.ROPE[2048])));
    constexpr int NITEM = 64 + 96 + 128;
    for (int k = 0; ; ++k) {
        const int item = (k & 1) ? (k + 1) * F.G - 1 - F.bid : k * F.G + F.bid;
        if (k * F.G >= NITEM) break;
        if (item >= NITEM) continue;
        const bool is_gla = item >= 64 && item < 160;
        if (!(sel == 0 || (sel < 3 && (sel == 1) == is_gla))) continue;
        if (is_gla) {
            int tid = F.tid; asm volatile("" : "+v"(tid));
            const int wave = __builtin_amdgcn_readfirstlane(tid >> 6);
            gla1_unit(F, lds + wave * GW_BYTES, (item - 64) * 8 + wave, tid & 63);
            asm volatile("s_waitcnt vmcnt(0) lgkmcnt(0)" ::: "memory"); __syncthreads();
        } else {
            int grp, b, h, qb;
            if (item < 64) { grp = 1; b = item >> 5; h = (item >> 3) & 3; qb = item & 7; } else { const int it = item - 160; grp = 0; b = it >> 3; h = (it >> 1) & 3; qb = it & 1; }
            attn_item<AVAR>(F, lds, grp, b, h, qb, lam);
        }
    }
}
__device__ __forceinline__ void ph_mix_b(const Frame& F) { for (int sq = F.bid; sq < 144; sq += F.G) gla2_scan(F, sq, F.tid); }
__device__ __forceinline__ void ph_mix_c(const Frame& F, LAS unsigned char* lds) {
    for (int slot = F.bid; slot < 96; slot += F.G) {
        int tid = F.tid; asm volatile("" : "+v"(tid));
        const int wave = __builtin_amdgcn_readfirstlane(tid >> 6);
        gla3_unit(F, lds + wave * GW_BYTES, slot * 8 + wave, tid & 63);
    }
}

__device__ void ph_merge(const Frame& F) {
    for (int r = F.bid * 8 + F.wave; r < NT; r += F.G * 8) {
#pragma unroll
        for (int g = 0; g < 1; ++g)
#pragma unroll
            for (int h = 0; h < 4; ++h) {
                const int c = h * 128 + F.lane * 2;
                float2 v;
                if (g == 0) { const float2 a = *(const float2*)(F.OGF + (size_t)r * 512 + c), bb = *(const float2*)(F.OGB + (size_t)r * 512 + c); v.x = a.x + bb.x; v.y = a.y + bb.y; }
                else v = *(const float2*)(F.OD + (size_t)r * 512 + c);
                const float ss = wave_sum(v.x * v.x + v.y * v.y);
                const float rstd = 1.0f / sqrtf(ss * (1.0f / 128.0f) + 1e-6f);
                const float* gain = (g == 0 ? F.gla_gain : F.diff_gain) + F.lane * 2;
                const float sc = g == 0 ? 1.0f : 0.8f;
                const float2 gt = *(const float2*)(F.P + (size_t)r * PW + C_GATE + g * 512 + c);
                float2 o; o.x = v.x * rstd * gain[0] * sc * silu_f(gt.x); o.y = v.y * rstd * gain[1] * sc * silu_f(gt.y);
                *(unsigned*)(F.MGB + (size_t)r * D + g * 512 + c) = pk2(o.x, o.y);
            }
    }
}
__device__ __forceinline__ void ph_final(const Frame& F) {
    for (int r = F.bid * 8 + F.wave; r < NT; r += F.G * 8) {
        float* y = F.out + (size_t)r * D;
        float4 v[4]; float ss = 0.f;
#pragma unroll
        for (int i = 0; i < 4; ++i) { v[i] = *(const float4*)(y + i * 256 + F.lane * 4); ss += v[i].x * v[i].x + v[i].y * v[i].y + v[i].z * v[i].z + v[i].w * v[i].w; }
        ss = wave_sum(ss);
        const float rstd = 1.0f / sqrtf(ss * (1.0f / 1024.0f) + 1e-6f);
#pragma unroll
        for (int i = 0; i < 4; ++i) {
            const int k = i * 256 + F.lane * 4; const float4 g = *(const float4*)(F.final_gain + k);
            float4 o; o.x = v[i].x * rstd * g.x; o.y = v[i].y * rstd * g.y; o.z = v[i].z * rstd * g.z; o.w = v[i].w * rstd * g.w;
            *(float4*)(y + k) = o;
        }
    }
}


__device__ __forceinline__ void frame_derive(Frame& F, unsigned char* ws0) {
    size_t zoff = 0; asm volatile("" : "+s"(zoff));
    unsigned char* ws = ws0 + zoff;
    F.ws = ws;
    F.MOD = (float*)(ws + WS_MOD); F.H = nullptr; F.P = (float*)(ws + WS_P);
    F.OGF = (float*)(ws + WS_OGF); F.OGB = (float*)(ws + WS_OGB); F.OD = (float*)(ws + WS_OD); F.MG = (float*)(ws + WS_MG);
    F.ROPE = (float*)(ws + WS_ROPE); F.LR = (float*)(ws + WS_LR);
    F.WINT = (bf16_t*)(ws + WS_WINT); F.WOT = (bf16_t*)(ws + WS_WOT); F.HB = (bf16_t*)(ws + WS_HB); F.QG = (bf16_t*)(ws + WS_QG); F.KG = (bf16_t*)(ws + WS_KG); F.VG = (bf16_t*)(ws + WS_VG);
    F.DQ = (bf16_t*)(ws + WS_DQ); F.DKP = (bf16_t*)(ws + WS_DKP); F.DVP = (bf16_t*)(ws + WS_DVP); F.DKS = (bf16_t*)(ws + WS_DKS); F.DVS = (bf16_t*)(ws + WS_DVS);
    F.SG = (bf16_t*)(ws + WS_SG); F.MGB = (bf16_t*)(ws + WS_MGB); F.VGT = (bf16_t*)(ws + WS_VGT); F.GSC = ws + WS_GSC;
}

#ifndef DEBUG_P
#define DEBUG_P 0
#endif
#ifndef PROBE_REPEAT
#define PROBE_REPEAT -1
#endif
#ifndef PROBE_AVAR
#define PROBE_AVAR 0
#endif
#ifndef PROBE_NREP
#define PROBE_NREP 2
#endif
constexpr int NPH = 6;
__global__ void __launch_bounds__(NTHR, 2) mega(Args args) {
    extern __shared__ __attribute__((aligned(16))) unsigned char lds_raw[];
    LAS unsigned char* lds = (LAS unsigned char*)lds_raw;
    Frame F;
    F.x_prompt = args.in[0]; F.x_sample = args.in[1]; F.cache_k = args.in[2]; F.cache_v = args.in[3]; F.st_f = args.in[4]; F.st_b = args.in[5];
    F.c = args.in[6]; F.c_ctx = args.in[7]; F.norm_gain = args.in[8]; F.w_mod = args.in[9]; F.b_mod = args.in[10]; F.w_in = args.in[11];
    F.w_alpha = args.in[12]; F.b_alpha = args.in[13]; F.dlam = args.in[14]; F.gla_gain = args.in[15]; F.diff_gain = args.in[16]; F.w_out = args.in[17]; F.final_gain = args.in[18];
    F.out = args.out; F.ws = args.ws;
    unsigned char* ws = args.ws;
    F.tid = threadIdx.x; F.lane = F.tid & 63; F.wave = F.tid >> 6; F.G = gridDim.x; F.bid = blockIdx.x;
    volatile LAS unsigned* misc = (volatile LAS unsigned*)(lds + LDS_BYTES - 64);
    if (F.tid < 16) misc[F.tid] = 0u;
    __syncthreads();
    const int lo = args.ph_lo, hi = args.ph_hi;
    XcdBarrier bar; bar.bar = (unsigned*)(ws + WS_CTL) + 1024; bar.x = 0; bar.st = nullptr;
    if (hi - lo > 1) bar = xcd_barrier_post((unsigned*)(ws + WS_CTL) + 1024, misc);
#define IN(k) (lo <= (k) && (k) < hi)
#define SEAM(k) do { if (IN(k) && IN((k) + 1)) xcd_barrier(bar); } while (0)
    LAS float* ldsf = (LAS float*)lds;
#define REPS(k) for (int rep = 0; rep < (PROBE_REPEAT == (k) ? PROBE_NREP : 1); ++rep)
#define REPBAR() do { if (rep) xcd_barrier(bar); } while (0)
    if (IN(0)) { REPS(0) { REPBAR(); frame_derive(F, ws); ph_prep(F, lds, rep == 0); } } SEAM(0);
    if (IN(1)) { REPS(1) { REPBAR(); frame_derive(F, ws); ph_hb(F); } } SEAM(1);
    if (IN(2)) {
        REPS(2) { REPBAR();
        frame_derive(F, ws);
        pg8::Gemm g{F.HB, F.WINT, NT, NIN, D}; pg8::StaticOrder S; S.init(NT, NIN, F.G, F.bid);
        EpiInFast E{F.QG, F.KG, F.VGT, F.DQ, F.DKP, F.DVP, F.DKS, F.DVS, F.SG, F.LR, F.out, F.ROPE, DEBUG_P ? F.P : nullptr};
        pg8::gemm_phase<EpiInFast, pg8::StaticOrder, true, true>(lds, g, S, E);
        }
    } SEAM(2);
    if (IN(3)) {
        if (PROBE_REPEAT == 3 && PROBE_AVAR != 0) { frame_derive(F, ws); ph_mix_a<PROBE_AVAR>(F, lds, 2); xcd_barrier(bar); }
        REPS(3) { REPBAR(); frame_derive(F, ws); ph_mix_a<0>(F, lds, rep ? PROBE_MIXSEL : 0); }
        xcd_barrier(bar);
        frame_derive(F, ws); ph_mix_b(F);
        xcd_barrier(bar);
        frame_derive(F, ws); ph_mix_c(F, lds);
    } SEAM(3);
    if (IN(4)) {
        REPS(4) { REPBAR();
        frame_derive(F, ws);
        pg8::Gemm g{F.MGB, F.WOT, NT, D, D}; pg8::StaticOrder S; S.init(NT, D, F.G, F.bid);
        EpiOutFast E{F.x_prompt, F.x_sample, F.MOD, F.out};
        pg8::gemm_phase<EpiOutFast, pg8::StaticOrder, true, true>(lds, g, S, E);
        }
    } SEAM(4);
    if (IN(5)) { frame_derive(F, ws); ph_final(F); }
#undef IN
#undef SEAM
}

extern "C" void kernel_launch(void* const* d_in, const int* in_sizes, int n_in, void* d_out, int out_size, void* d_ws, size_t ws_size, hipStream_t stream) {
    static int grid = 0;
    if (grid == 0) {
        if (n_in != 19 || out_size != 11534336 || ws_size < WS_END) { fprintf(stderr, "kernel_launch: unexpected shapes n_in %d out %d ws %zu\n", n_in, out_size, ws_size); grid = -1; return; }
        int dev = 0, cus = 0;
        if (hipGetDevice(&dev) != hipSuccess || hipDeviceGetAttribute(&cus, hipDeviceAttributeMultiprocessorCount, dev) != hipSuccess) { grid = -1; return; }
        if (hipFuncSetAttribute((const void*)mega, hipFuncAttributeMaxDynamicSharedMemorySize, LDS_BYTES) != hipSuccess) { fprintf(stderr, "kernel_launch: hipFuncSetAttribute failed\n"); grid = -1; return; }
        grid = cus;
    }
    if (grid < 0) return;
    (void)hipMemsetAsync((char*)d_ws + WS_CTL, 0, CTL_ZERO_BYTES, stream);
    Args a{};
    for (int i = 0; i < 19; ++i) a.in[i] = (const float*)d_in[i];
    a.out = (float*)d_out; a.ws = (unsigned char*)d_ws;
    if (MK_N_LAUNCHES == 1) {
        a.ph_lo = 0; a.ph_hi = NPH;
        hipLaunchKernelGGL(mega, dim3(grid), dim3(NTHR), LDS_BYTES, stream, a);
    } else {
        for (int p = 0; p < NPH; ++p) { a.ph_lo = p; a.ph_hi = p + 1; hipLaunchKernelGGL(mega, dim3(grid), dim3(NTHR), LDS_BYTES, stream, a); }
    }
}
```

```cpp
#include <hip/hip_runtime.h>
#include <cstdio>
#include <cstdint>

#ifndef MK_N_LAUNCHES
#define MK_N_LAUNCHES 1
#endif

constexpr int D = 1024, NPR = 4096, NSR = 2048, NT = 6144, PW = 3616;
constexpr int C_GQ = 0, C_GK = 256, C_GV = 512, C_LRF = 1024, C_LRB = 1040, C_DQ = 1056, C_DK = 1568, C_DV = 2080, C_GATE = 2592;
constexpr size_t O_Y = 0, O_NK = 6291456, O_NV = 8388608, O_SF = 10485760, O_SB = 11010048;
constexpr int NTHR = 512;
constexpr int LDS_BYTES = 147456;

constexpr size_t MiB = 1u << 20;
constexpr size_t WS_CTL = 0, CTL_ZERO_BYTES = 64 * 1024;
constexpr size_t WS_TS = 19456;
constexpr size_t WS_QHEAD = 18432;
constexpr size_t WS_ATCNT = 61440;
constexpr size_t WS_ATP = 142 * MiB;
constexpr size_t WS_SEQCNT = 20480;
constexpr size_t WS_MOD = 24576;
constexpr size_t WS_ROPE = 64 * 1024;
constexpr size_t WS_WINT = 1 * MiB;
constexpr size_t WS_WOT = 9 * MiB;
constexpr size_t WS_HB = 12 * MiB;
constexpr size_t WS_QG = 24 * MiB, WS_KG = 27 * MiB;
constexpr size_t WS_VG = 30 * MiB;
constexpr size_t WS_DQ = 36 * MiB;
constexpr size_t WS_DKP = 42 * MiB, WS_DVP = 46 * MiB;
constexpr size_t WS_DKS = 50 * MiB, WS_DVS = 53 * MiB;
constexpr size_t WS_SG = 56 * MiB;
constexpr size_t WS_LR = 68 * MiB;
constexpr size_t WS_MGB = 70 * MiB;
constexpr size_t WS_VGT = 82 * MiB;
constexpr size_t WS_GSC = 90 * MiB;
constexpr size_t WS_P = 84 * MiB;
constexpr size_t WS_OGF = 170 * MiB;
constexpr size_t WS_OGB = 182 * MiB;
constexpr size_t WS_OD = 194 * MiB;
constexpr size_t WS_MG = 206 * MiB;
constexpr size_t WS_END = 230 * MiB;
constexpr int NIN = 3584;

#define LAS __attribute__((address_space(3)))

#define XB_TMO      128
#define XB_XCNT(j)  (256  + 64 * (j))
#define XB_XSUB(j)  (1280 + 64 * (j))
#define XB_XGEN(j)  (2304 + 64 * (j))
#define XB_TOP      3328
#define XB_TOPGEN   3392
#define XCD_BAR_WORDS 3456
#define XB_SPIN_CAP (1u << 18)
__device__ __forceinline__ unsigned xb_ld(unsigned* p)              { return __hip_atomic_load(p, __ATOMIC_RELAXED, __HIP_MEMORY_SCOPE_AGENT); }
__device__ __forceinline__ unsigned xb_add(unsigned* p, unsigned v) { return __hip_atomic_fetch_add(p, v, __ATOMIC_RELAXED, __HIP_MEMORY_SCOPE_AGENT); }
__device__ __forceinline__ unsigned xb_xcc_id() { return (unsigned)__builtin_amdgcn_s_getreg((3 << 11) | 20) & 0xFu; }
#define XB_SPIN(cond, bar) do { unsigned _sp = 0; while (cond) { __builtin_amdgcn_s_sleep(1); \
    if ((++_sp & 255u) == 0u) { if (xb_ld(&(bar)[XB_TMO])) break; if (_sp > XB_SPIN_CAP) { atomicAdd(&(bar)[XB_TMO], 1u); break; } } } } while (0)
struct XcdBarrier { unsigned* bar; unsigned x; volatile LAS unsigned* st; };
__device__ __forceinline__ XcdBarrier xcd_barrier_post(unsigned* bar, volatile LAS unsigned* st) {
    XcdBarrier b; b.bar = bar; b.x = xb_xcc_id(); b.st = st;
    if (threadIdx.x == 0) (void)xb_add(&bar[XB_XCNT(b.x)], 1u);
    return b;
}
__device__ __forceinline__ void xcd_barrier_complete(unsigned* bar, unsigned x, unsigned& nloc, unsigned& nx) {
    const unsigned G = gridDim.x * gridDim.y * gridDim.z;
    unsigned sum, cnt, mine, sp = 0u;
    for (;;) {
        sum = 0u; cnt = 0u; mine = 0u;
#pragma unroll
        for (unsigned j = 0; j < 16; ++j) { const unsigned c = xb_ld(&bar[XB_XCNT(j)]); sum += c; cnt += (c > 0u) ? 1u : 0u; mine = (j == x) ? c : mine; }
        if (sum == G) break;
        __builtin_amdgcn_s_sleep(1);
        if ((++sp & 255u) == 0u) { if (xb_ld(&bar[XB_TMO])) break; if (sp > XB_SPIN_CAP) { atomicAdd(&bar[XB_TMO], 1u); break; } }
    }
    nloc = mine > 0u ? mine : 1u; nx = cnt > 0u ? cnt : 1u;
}
__device__ __forceinline__ void xcd_barrier(const XcdBarrier& b) {
    asm volatile("s_waitcnt vmcnt(0)" ::: "memory");
    __syncthreads();
    if (threadIdx.x == 0) {
        unsigned* bar = b.bar;
        __builtin_amdgcn_s_waitcnt(0);
        unsigned nloc = b.st[0], nx = b.st[1];
        if (nloc == 0u) { xcd_barrier_complete(bar, b.x, nloc, nx); b.st[0] = nloc; b.st[1] = nx; }
        const unsigned old = xb_add(&bar[XB_XSUB(b.x)], 1u);
        const unsigned gen = old / nloc;
        if (old + 1u == (gen + 1u) * nloc) {
            __builtin_amdgcn_fence(__ATOMIC_RELEASE, "agent");
            asm volatile("s_waitcnt vmcnt(0)" ::: "memory");
            const unsigned og = xb_add(&bar[XB_TOP], 1u);
            const unsigned tg = og / nx;
            if (og + 1u == (tg + 1u) * nx) xb_add(&bar[XB_TOPGEN], 1u);
            else XB_SPIN(xb_ld(&bar[XB_TOPGEN]) == tg, bar);
            __builtin_amdgcn_fence(__ATOMIC_ACQUIRE, "agent");
            xb_add(&bar[XB_XGEN(b.x)], 1u);
            asm volatile("s_waitcnt vmcnt(0)" ::: "memory");
        } else {
            XB_SPIN(xb_ld(&bar[XB_XGEN(b.x)]) == gen, bar);
            __builtin_amdgcn_fence(__ATOMIC_ACQUIRE, "agent");
            asm volatile("s_waitcnt vmcnt(0)" ::: "memory");
        }
    }
    __syncthreads();
}

namespace pg8 {
#define PG8_LAS __attribute__((address_space(3)))
typedef unsigned short bf16_t;
typedef short bf16x8 __attribute__((ext_vector_type(8)));
typedef float f32x4 __attribute__((ext_vector_type(4)));
typedef unsigned u32x4 __attribute__((ext_vector_type(4)));
constexpr int BM = 256, BK = 64, HALF = 128, HTB = HALF * BK * 2  , STAGE_BYTES = 8 * HTB, NXCD = 8, WGM = 8;

__host__ __device__ __forceinline__ int lds_byte(int r, int c) { const int st = (r >> 4) * 2 + (c >> 5), rr = r & 15, cc = c & 31, ob = rr * 64 + cc * 2; return st * 1024 + (ob ^ (((ob >> 9) & 1) << 5)); }
__host__ __device__ __forceinline__ void stage_rc(int b, int& R, int& C) { const int st = b / 1024, sb = b % 1024, swz = sb ^ (((sb >> 9) & 1) << 5); R = (st >> 1) * 16 + swz / 64; C = (st & 1) * 32 + (swz % 64) / 2; }
__host__ __device__ __forceinline__ int perm32(int rho) { const int n = rho >> 4, i = rho & 15; return 8 * (i >> 2) + 4 * n + (i & 3); }

struct Unit { int pm, pn; };
struct Gemm { const bf16_t* A; const bf16_t* Bt; int M, N, K; };

struct StaticOrder {
    int nM, nN, nwg, G, c;
    __host__ __device__ void init(int M, int N, int G_, int c_) { nM = M / BM; nN = N / BM; nwg = nM * nN; G = G_; c = c_; }
    __host__ __device__ bool next(int i, Unit& u) const {
        const long L = (long)i * G + c; if (L >= nwg) return false;
        int wgid = (int)L; { const int q = nwg / NXCD, r = nwg % NXCD, xcd = wgid % NXCD, off = wgid / NXCD; wgid = (xcd < r ? xcd * (q + 1) : r * (q + 1) + (xcd - r) * q) + off; }
        const int nig = WGM * nN, gid = wgid / nig, fm = gid * WGM, gsz = (nM - fm) < WGM ? (nM - fm) : WGM;
        u.pm = fm + ((wgid % nig) % gsz); u.pn = (wgid % nig) / gsz; return true;
    }
    __device__ __forceinline__ void a_ready(const Unit&) const {}
    __device__ __forceinline__ void done(const Unit&) const {}
};

__device__ __forceinline__ unsigned cvt_pk_bf16(float lo, float hi) { unsigned r; asm volatile("v_cvt_pk_bf16_f32 %0, %1, %2" : "=v"(r) : "v"(lo), "v"(hi)); return r; }
template <class Epi, class Sched, bool ALIGN_EPI = false, bool SP2 = false>
__device__ __forceinline__ void gemm_phase(PG8_LAS unsigned char* lds, const Gemm g, const Sched& S, const Epi& E) {
    const int tid = threadIdx.x, wid = __builtin_amdgcn_readfirstlane(tid >> 6), lane = tid & 63, wr = wid >> 2, wc = wid & 3, fr = lane & 15, fq = lane >> 4;
    const int K = g.K, nt = K / BK;
    unsigned voffA[2], voffB[2];
#pragma unroll
    for (int i = 0; i < 2; ++i) { int R, C; stage_rc(tid * 16 + i * 8192, R, C); const int Rb = Epi::PERM ? ((R & ~31) + perm32(R & 31)) : R;
        voffA[i] = (unsigned)(R * K + C) * 2u; voffB[i] = (unsigned)(Rb * K + C) * 2u; }
    const size_t kstep = (size_t)(BK * 2);
    const size_t hstep = (size_t)HALF * K * 2;
    const size_t tstep = 2 * hstep;
    const unsigned ldsw = (unsigned)wid * 1024u;
    const int aoff = lds_byte(wr * 64 + fr, fq * 8), boff = lds_byte(wc * 32 + fr, fq * 8);
#define PG8_SA(b, h) (((b) * 2 + (h)) * HTB)
#define PG8_SB(b, h) ((4 + (b) * 2 + (h)) * HTB)
#define PG8_STAGE(bufoff, gbase, voff) do { _Pragma("unroll") for (int _i = 0; _i < 2; ++_i) \
        __builtin_amdgcn_global_load_lds((const unsigned*)((const char*)(gbase) + (voff)[_i]), (PG8_LAS unsigned*)(lds + (bufoff) + ldsw + _i * 8192), 16, 0, 0); } while (0)
#define PG8_LDA(dst, b, h) do { _Pragma("unroll") for (int m = 0; m < 4; ++m) _Pragma("unroll") for (int k = 0; k < 2; ++k) dst[m][k] = *(const PG8_LAS bf16x8*)(lds + PG8_SA(b, h) + aoff + m * 2048 + k * 1024); } while (0)
#define PG8_LDB(dst, b, h) do { _Pragma("unroll") for (int n = 0; n < 2; ++n) _Pragma("unroll") for (int k = 0; k < 2; ++k) dst[n][k] = *(const PG8_LAS bf16x8*)(lds + PG8_SB(b, h) + boff + n * 2048 + k * 1024); } while (0)
#define PG8_MMA(ai, bj, At, Bt) do { __builtin_amdgcn_s_setprio(1); _Pragma("unroll") for (int m = 0; m < 4; ++m) _Pragma("unroll") for (int n = 0; n < 2; ++n) _Pragma("unroll") for (int k = 0; k < 2; ++k) \
        acc[ai][bj][m][n] = __builtin_amdgcn_mfma_f32_16x16x32_bf16(Bt[n][k], At[m][k], acc[ai][bj][m][n], 0, 0, 0); __builtin_amdgcn_s_setprio(0); } while (0)
#define PG8_WAIT_V(n) asm volatile("s_waitcnt vmcnt(" #n ")" ::: "memory")
#define PG8_WAIT_L(n) asm volatile("s_waitcnt lgkmcnt(" #n ")" ::: "memory")
#define PG8_BAR __builtin_amdgcn_s_barrier()
#define PG8_SCHED __builtin_amdgcn_sched_barrier(0)
    Unit cur, nxt; int ui = 0;
    if (!S.next(0, cur)) return;
    f32x4 acc[2][2][4][2];
#pragma unroll
    for (int a = 0; a < 2; ++a)
#pragma unroll
        for (int b = 0; b < 2; ++b)
#pragma unroll
            for (int m = 0; m < 4; ++m)
#pragma unroll
                for (int n = 0; n < 2; ++n) acc[a][b][m][n] = (f32x4){0.f, 0.f, 0.f, 0.f};
    bf16x8 At[4][2], B0[2][2], B1[2][2];
    const char* cA = (const char*)g.A + (size_t)cur.pm * tstep; const char* cB = (const char*)g.Bt + (size_t)cur.pn * tstep;
    S.a_ready(cur);
    if constexpr (SP2) {
        PG8_STAGE(PG8_SB(0, 0), cB, voffB); PG8_STAGE(PG8_SB(0, 1), cB + hstep, voffB); PG8_STAGE(PG8_SA(0, 0), cA, voffA); PG8_STAGE(PG8_SA(0, 1), cA + hstep, voffA);
        if (wr == 1) PG8_BAR;
        PG8_WAIT_V(2); PG8_BAR;
        PG8_STAGE(PG8_SB(1, 0), cB + kstep, voffB); PG8_STAGE(PG8_SA(1, 0), cA + kstep, voffA); PG8_STAGE(PG8_SB(1, 1), cB + hstep + kstep, voffB);
        PG8_WAIT_V(6); PG8_BAR;
    } else {
        PG8_STAGE(PG8_SB(0, 0), cB, voffB); PG8_STAGE(PG8_SA(0, 0), cA, voffA); PG8_STAGE(PG8_SB(0, 1), cB + hstep, voffB); PG8_STAGE(PG8_SA(0, 1), cA + hstep, voffA);
        if (wr == 1) PG8_BAR;
        PG8_WAIT_V(4); PG8_BAR;
        PG8_STAGE(PG8_SB(1, 0), cB + kstep, voffB); PG8_STAGE(PG8_SA(1, 0), cA + kstep, voffA); PG8_STAGE(PG8_SB(1, 1), cB + hstep + kstep, voffB);
        PG8_WAIT_V(6); PG8_BAR;
    }
    for (;;) {
        const bool has_next = S.next(ui + 1, nxt);
        const char* nA = has_next ? (const char*)g.A + (size_t)nxt.pm * tstep : cA; const char* nB = has_next ? (const char*)g.Bt + (size_t)nxt.pn * tstep : cB;
        for (int t = 0; t < nt; t += 2) {
            const bool last = (t == nt - 2);
            const char* a1 = cA + (size_t)(t + 1) * kstep;
            const char* a2 = last ? nA : cA + (size_t)(t + 2) * kstep; const char* b2 = last ? nB : cB + (size_t)(t + 2) * kstep;
            const char* a3 = a2 + kstep; const char* b3 = b2 + kstep;
            if (last && has_next) S.a_ready(nxt);
            if constexpr (SP2) {
            PG8_LDB(B0, 0, 0); PG8_LDB(B1, 0, 1); PG8_SCHED; PG8_LDA(At, 0, 0); PG8_STAGE(PG8_SA(1, 1), a1 + hstep, voffA);
            PG8_WAIT_V(8); PG8_WAIT_L(0); PG8_BAR; PG8_MMA(0, 0, At, B0); PG8_MMA(0, 1, At, B1); PG8_BAR; PG8_SCHED;
            PG8_LDA(At, 0, 1); PG8_STAGE(PG8_SB(0, 0), b2, voffB); PG8_STAGE(PG8_SB(0, 1), b2 + hstep, voffB); PG8_STAGE(PG8_SA(0, 0), a2, voffA);
            PG8_WAIT_V(8); PG8_WAIT_L(0); PG8_BAR; PG8_MMA(1, 0, At, B0); PG8_MMA(1, 1, At, B1); PG8_BAR; PG8_SCHED;
            PG8_LDB(B0, 1, 0); PG8_LDB(B1, 1, 1); PG8_SCHED; PG8_LDA(At, 1, 0); PG8_STAGE(PG8_SA(0, 1), a2 + hstep, voffA);
            PG8_WAIT_V(8); PG8_WAIT_L(0); PG8_BAR; PG8_MMA(0, 0, At, B0); PG8_MMA(0, 1, At, B1); PG8_BAR; PG8_SCHED;
            PG8_LDA(At, 1, 1); PG8_STAGE(PG8_SB(1, 0), b3, voffB); PG8_STAGE(PG8_SB(1, 1), b3 + hstep, voffB); PG8_STAGE(PG8_SA(1, 0), a3, voffA);
            PG8_WAIT_V(8); PG8_WAIT_L(0); PG8_BAR; PG8_MMA(1, 0, At, B0); PG8_MMA(1, 1, At, B1); PG8_BAR; PG8_SCHED;
            } else {
            PG8_LDB(B0, 0, 0); PG8_SCHED; PG8_LDA(At, 0, 0); PG8_STAGE(PG8_SA(1, 1), a1 + hstep, voffA);
            PG8_WAIT_L(8); PG8_BAR; PG8_WAIT_L(0); PG8_MMA(0, 0, At, B0); PG8_BAR; PG8_SCHED;
            PG8_LDB(B1, 0, 1); PG8_STAGE(PG8_SB(0, 0), b2, voffB);
            PG8_BAR; PG8_WAIT_L(0); PG8_MMA(0, 1, At, B1); PG8_BAR;
            PG8_LDA(At, 0, 1); PG8_STAGE(PG8_SA(0, 0), a2, voffA);
            PG8_BAR; PG8_WAIT_L(0); PG8_MMA(1, 0, At, B0); PG8_BAR; PG8_SCHED;
            PG8_STAGE(PG8_SB(0, 1), b2 + hstep, voffB);
            PG8_WAIT_V(6); PG8_BAR; PG8_MMA(1, 1, At, B1); PG8_BAR;
            PG8_LDB(B0, 1, 0); PG8_SCHED; PG8_LDA(At, 1, 0); PG8_STAGE(PG8_SA(0, 1), a2 + hstep, voffA);
            PG8_WAIT_L(8); PG8_BAR; PG8_WAIT_L(0); PG8_MMA(0, 0, At, B0); PG8_BAR; PG8_SCHED;
            PG8_LDB(B1, 1, 1); PG8_STAGE(PG8_SB(1, 0), b3, voffB);
            PG8_BAR; PG8_WAIT_L(0); PG8_MMA(0, 1, At, B1); PG8_BAR;
            PG8_LDA(At, 1, 1); PG8_STAGE(PG8_SA(1, 0), a3, voffA);
            PG8_BAR; PG8_WAIT_L(0); PG8_MMA(1, 0, At, B0); PG8_BAR; PG8_SCHED;
            PG8_STAGE(PG8_SB(1, 1), b3 + hstep, voffB);
            PG8_WAIT_V(6); PG8_BAR; PG8_MMA(1, 1, At, B1); PG8_BAR;
            }
        }
        if constexpr (ALIGN_EPI) { if (wr == 0) PG8_BAR; }
        if constexpr (!Epi::AFTER_DRAIN) { E(acc, cur, wr, wc, fr, fq); S.done(cur); }
        if (!has_next) break;
#pragma unroll
        for (int a = 0; a < 2; ++a)
#pragma unroll
            for (int b = 0; b < 2; ++b)
#pragma unroll
                for (int m = 0; m < 4; ++m)
#pragma unroll
                    for (int n = 0; n < 2; ++n) acc[a][b][m][n] = (f32x4){0.f, 0.f, 0.f, 0.f};
        cur = nxt; cA = nA; cB = nB; ++ui;
        if constexpr (ALIGN_EPI) { if (wr == 1) PG8_BAR; }
    }
    PG8_WAIT_V(0);
    if constexpr (!ALIGN_EPI) { if (wr == 0) PG8_BAR; }
    PG8_BAR;
    if constexpr (Epi::AFTER_DRAIN) { E.fused(acc, cur, wr, wc, fr, fq, lds, wid, lane); S.done(cur); }
#undef PG8_SA
#undef PG8_SB
#undef PG8_STAGE
#undef PG8_LDA
#undef PG8_LDB
#undef PG8_MMA
#undef PG8_WAIT_V
#undef PG8_WAIT_L
#undef PG8_BAR
#undef PG8_SCHED
}
}

struct Args {
    const float* in[19]; float* out; unsigned char* ws; int ph_lo, ph_hi;
    int rp, nr, msel, pad;
};
struct Frame {
    const float *x_prompt, *x_sample, *cache_k, *cache_v, *st_f, *st_b, *c, *c_ctx, *norm_gain, *w_mod, *b_mod, *w_in, *w_alpha, *b_alpha, *dlam, *gla_gain, *diff_gain, *w_out, *final_gain;
    float* out; unsigned char* ws;
    float *MOD, *H, *P, *OGF, *OGB, *OD, *MG;
    float *ROPE, *LR;
    unsigned short *WINT, *WOT, *HB, *QG, *KG, *VG, *DQ, *DKP, *DVP, *DKS, *DVS, *SG, *MGB, *VGT;
    unsigned char* GSC;
    int tid, lane, wave, G, bid;
};
__device__ __forceinline__ float wave_sum(float v) {
#pragma unroll
    for (int o = 32; o > 0; o >>= 1) v += __shfl_xor(v, o);
    return v;
}
__device__ __forceinline__ float wave_max(float v) {
#pragma unroll
    for (int o = 32; o > 0; o >>= 1) v = fmaxf(v, __shfl_xor(v, o));
    return v;
}
__device__ __forceinline__ float silu_f(float x) { return x / (1.0f + expf(-x)); }
__device__ __forceinline__ const float* xrow(const Frame& F, int r) { return r < NPR ? F.x_prompt + (size_t)r * D : F.x_sample + (size_t)(r - NPR) * D; }
__device__ __forceinline__ int variant_of(int r) { return r < NPR ? 0 : 1 + (r - NPR) / 1024; }
__device__ __forceinline__ float lam_value(const Frame& F) {
    float a = 0.f, b = 0.f;
    for (int i = 0; i < 64; ++i) { a += F.dlam[i] * F.dlam[64 + i]; b += F.dlam[128 + i] * F.dlam[192 + i]; }
    return expf(a) - expf(b) + 0.2f;
}

__device__ void ph_mod(const Frame& F) {
    for (int e = F.bid * NTHR + F.tid; e < 3072; e += F.G * NTHR) {
        float a0 = 0.f, a1 = 0.f, a2 = 0.f;
        for (int d = 0; d < D; ++d) {
            const float w = F.w_mod[(size_t)d * 3072 + e];
            a0 += silu_f(F.c_ctx[d]) * w; a1 += silu_f(F.c[d]) * w; a2 += silu_f(F.c[D + d]) * w;
        }
        const float bb = F.b_mod[e];
        F.MOD[e] = a0 + bb; F.MOD[3072 + e] = a1 + bb; F.MOD[6144 + e] = a2 + bb;
    }
}
__device__ void ph_h(const Frame& F) {
    for (int r = F.bid * 8 + F.wave; r < NT; r += F.G * 8) {
        const float* x = xrow(F, r); const float* m = F.MOD + variant_of(r) * 3072;
        float4 v[4]; float ss = 0.f;
#pragma unroll
        for (int i = 0; i < 4; ++i) { v[i] = *(const float4*)(x + i * 256 + F.lane * 4); ss += v[i].x * v[i].x + v[i].y * v[i].y + v[i].z * v[i].z + v[i].w * v[i].w; }
        ss = wave_sum(ss);
        const float rstd = 1.0f / sqrtf(ss * (1.0f / 1024.0f) + 1e-6f);
#pragma unroll
        for (int i = 0; i < 4; ++i) {
            const int k = i * 256 + F.lane * 4;
            const float4 g = *(const float4*)(F.norm_gain + k), sh = *(const float4*)(m + k), sc = *(const float4*)(m + 1024 + k);
            float4 o;
            o.x = v[i].x * rstd * g.x * (1.0f + sc.x) + sh.x; o.y = v[i].y * rstd * g.y * (1.0f + sc.y) + sh.y;
            o.z = v[i].z * rstd * g.z * (1.0f + sc.z) + sh.z; o.w = v[i].w * rstd * g.w * (1.0f + sc.w) + sh.w;
            *(float4*)(F.H + (size_t)r * D + k) = o;
        }
    }
}
template <class Epi>
__device__ void gemm_naive(const Frame& F, LAS float* lds, const float* A, int lda, const float* B, int ldb, int M, int N, int K, const Epi& E) {
    LAS float* As = lds;
    LAS float* Bs = lds + 16 * 132;
    const int ntn = (N + 63) / 64, ntm = M / 128, nt = ntn * ntm;
    const int tid = F.tid, ty = tid >> 4, tx = tid & 15;
    for (int t = F.bid; t < nt; t += F.G) {
        const int tm = t / ntn, tn = t % ntn, row0 = tm * 128, col0 = tn * 64;
        float acc[4][4];
#pragma unroll
        for (int i = 0; i < 4; ++i)
#pragma unroll
            for (int j = 0; j < 4; ++j) acc[i][j] = 0.f;
        for (int k0 = 0; k0 < K; k0 += 16) {
            { const int r = tid >> 2, kq = (tid & 3) * 4; const float4 a = *(const float4*)(A + (size_t)(row0 + r) * lda + k0 + kq);
              As[(kq + 0) * 132 + r] = a.x; As[(kq + 1) * 132 + r] = a.y; As[(kq + 2) * 132 + r] = a.z; As[(kq + 3) * 132 + r] = a.w; }
            { const int k = tid >> 5, c = (tid & 31) * 2; float2 b = make_float2(0.f, 0.f); if (col0 + c < N) b = *(const float2*)(B + (size_t)(k0 + k) * ldb + col0 + c);
              Bs[k * 64 + c] = b.x; Bs[k * 64 + c + 1] = b.y; }
            __syncthreads();
#pragma unroll
            for (int kk = 0; kk < 16; ++kk) {
                float a[4], b[4];
#pragma unroll
                for (int i = 0; i < 4; ++i) { a[i] = As[kk * 132 + ty * 4 + i]; b[i] = Bs[kk * 64 + tx * 4 + i]; }
#pragma unroll
                for (int i = 0; i < 4; ++i)
#pragma unroll
                    for (int j = 0; j < 4; ++j) acc[i][j] += a[i] * b[j];
            }
            __syncthreads();
        }
#pragma unroll
        for (int i = 0; i < 4; ++i)
#pragma unroll
            for (int j = 0; j < 4; ++j) { const int r = row0 + ty * 4 + i, c = col0 + tx * 4 + j; if (c < N) E(r, c, acc[i][j]); }
    }
}
struct EpiIn { float* P; float* out;
    __device__ __forceinline__ void operator()(int r, int c, float v) const {
        P[(size_t)r * PW + c] = v;
        if (r < NPR) { if (c >= C_DK && c < C_DV) out[O_NK + (size_t)r * 512 + (c - C_DK)] = v; else if (c >= C_DV && c < C_GATE) out[O_NV + (size_t)r * 512 + (c - C_DV)] = v; }
    } };
struct EpiOut { const Frame* F;
    __device__ __forceinline__ void operator()(int r, int c, float v) const {
        const float gt = F->MOD[variant_of(r) * 3072 + 2048 + c];
        F->out[(size_t)r * D + c] = xrow(*F, r)[c] + gt * v;
    } };
__device__ void ph_rope(const Frame& F) {
    const long total = (long)NSR * 512;
    for (long idx = (long)F.bid * NTHR + F.tid; idx < total; idx += (long)F.G * NTHR) {
        const int p = (int)(idx & 31), vec = (int)((idx >> 5) & 7), which = (int)((idx >> 8) & 1), rs = (int)(idx >> 9);
        const int t = rs & 1023, gr = t >> 6, gc = t & 63;
        const int i = p & 15; const int pos = p < 16 ? gr : gc; const int d1 = (p < 16 ? 0 : 32) + i, d2 = d1 + 16;
        const float inv = powf(10000.0f, -(float)i / 16.0f);
        const float ang = (float)pos * inv, cs = cosf(ang), sn = sinf(ang);
        float* base = F.P + (size_t)(NPR + rs) * PW + (which ? C_DK : C_DQ) + vec * 64;
        const float v1 = base[d1], v2 = base[d2];
        base[d1] = v1 * cs - v2 * sn; base[d2] = v1 * sn + v2 * cs;
    }
}
__device__ __forceinline__ float log_sigmoid_f(float z) { return fminf(z, 0.f) - log1pf(expf(-fabsf(z))); }
__device__ void ph_gla(const Frame& F, LAS float* lds) {
    LAS float* al = lds;
    LAS float* qs = al + 4096;
    LAS float* ks = qs + 4096;
    LAS float* vs = ks + 4096;
    LAS float* po = vs + 8192;
    const int tid = F.tid, j = tid & 127, kq = tid >> 7;
    for (int item = F.bid; item < 144; item += F.G) {
        int grp, b, h, dir;
        if (item < 128) { grp = 0; b = item >> 3; h = (item >> 1) & 3; dir = item & 1; } else { const int it = item - 128; grp = 1; b = it >> 3; h = (it >> 1) & 3; dir = it & 1; }
        const int R0 = grp == 0 ? b * 256 : NPR + b * 1024, n = grp == 0 ? 256 : 1024;
        float S[16];
        if (grp == 0) {
#pragma unroll
            for (int i = 0; i < 16; ++i) S[i] = 0.f;
        } else {
            const float* st = (dir == 0 ? F.st_f : F.st_b) + (size_t)(b * 4 + h) * 64 * 128;
#pragma unroll
            for (int i = 0; i < 16; ++i) S[i] = st[(kq * 16 + i) * 128 + j];
        }
        float* OG = dir == 0 ? F.OGF : F.OGB;
        for (int c0 = 0; c0 < n; c0 += 64) {
            __syncthreads();
            for (int e = tid; e < 4096; e += NTHR) {
                const int s = e >> 6, k = e & 63; const int t = dir == 0 ? c0 + s : n - 1 - (c0 + s); const float* prow = F.P + (size_t)(R0 + t) * PW;
                float z = F.b_alpha[dir * 256 + h * 64 + k];
                for (int r = 0; r < 16; ++r) z += prow[(dir == 0 ? C_LRF : C_LRB) + r] * F.w_alpha[(size_t)(dir * 16 + r) * 256 + h * 64 + k];
                al[e] = expf(log_sigmoid_f(z) * (1.0f / 16.0f));
                qs[e] = prow[C_GQ + h * 64 + k] * 0.125f;
                ks[e] = prow[C_GK + h * 64 + k];
            }
            for (int e = tid; e < 8192; e += NTHR) {
                const int s = e >> 7, jj = e & 127; const int t = dir == 0 ? c0 + s : n - 1 - (c0 + s);
                vs[e] = F.P[(size_t)(R0 + t) * PW + C_GV + h * 128 + jj];
            }
            __syncthreads();
            for (int s = 0; s < 64; ++s) {
                const float v = vs[s * 128 + j]; float o = 0.f;
#pragma unroll
                for (int i = 0; i < 16; ++i) { const int k = kq * 16 + i; S[i] = al[s * 64 + k] * S[i] + ks[s * 64 + k] * v; o += qs[s * 64 + k] * S[i]; }
                po[((s & 1) * 4 + kq) * 128 + j] = o;
                __syncthreads();
                if (kq == 0) {
                    const int t = dir == 0 ? c0 + s : n - 1 - (c0 + s);
                    const int pb = (s & 1) * 4;
                    OG[(size_t)(R0 + t) * 512 + h * 128 + j] = po[(pb + 0) * 128 + j] + po[(pb + 1) * 128 + j] + po[(pb + 2) * 128 + j] + po[(pb + 3) * 128 + j];
                }
            }
        }
        if (grp == 0) {
            float* so = F.out + (dir == 0 ? O_SF : O_SB) + (size_t)(b * 4 + h) * 64 * 128;
#pragma unroll
            for (int i = 0; i < 16; ++i) so[(kq * 16 + i) * 128 + j] = S[i];
        }
    }
}
__device__ void ph_diff(const Frame& F, LAS float* lds) {
    LAS float* wl = lds + F.wave * 3328;
    LAS float* qb = wl; LAS float* s1 = wl + 128; LAS float* s2 = s1 + 1536;
    const float lam = lam_value(F);
    const int lane = F.lane;
    for (int item = F.bid * 8 + F.wave; item < NT * 4; item += F.G * 8) {
        const int r = item >> 2, h = item & 3;
        int R0, nc, nk, b;
        if (r < NPR) { b = r >> 8; R0 = b * 256; nc = 0; nk = 256; } else { b = (r - NPR) >> 10; R0 = NPR + b * 1024; nc = 512; nk = 1536; }
        const float* qp = F.P + (size_t)r * PW + C_DQ + h * 128;
        qb[lane] = qp[lane]; qb[64 + lane] = qp[64 + lane];
        __builtin_amdgcn_wave_barrier();
        float m1 = -3.0e38f, m2 = -3.0e38f;
        for (int jk = lane; jk < nk; jk += 64) {
            const float* kp = jk < nc ? F.cache_k + ((size_t)(b * 512 + jk) * 4 + h) * 128 : F.P + (size_t)(R0 + jk - nc) * PW + C_DK + h * 128;
            float a1 = 0.f, a2 = 0.f;
            for (int d = 0; d < 64; d += 4) {
                const float4 k1 = *(const float4*)(kp + d), k2 = *(const float4*)(kp + 64 + d);
                a1 += qb[d] * k1.x + qb[d + 1] * k1.y + qb[d + 2] * k1.z + qb[d + 3] * k1.w;
                a2 += qb[64 + d] * k2.x + qb[64 + d + 1] * k2.y + qb[64 + d + 2] * k2.z + qb[64 + d + 3] * k2.w;
            }
            a1 *= 0.125f; a2 *= 0.125f; s1[jk] = a1; s2[jk] = a2; m1 = fmaxf(m1, a1); m2 = fmaxf(m2, a2);
        }
        m1 = wave_max(m1); m2 = wave_max(m2);
        float l1 = 0.f, l2 = 0.f;
        for (int jk = lane; jk < nk; jk += 64) { const float e1 = expf(s1[jk] - m1), e2 = expf(s2[jk] - m2); s1[jk] = e1; s2[jk] = e2; l1 += e1; l2 += e2; }
        l1 = wave_sum(l1); l2 = wave_sum(l2);
        const float i1 = 1.0f / l1, i2 = lam / l2;
        for (int jk = lane; jk < nk; jk += 64) s1[jk] = s1[jk] * i1 - s2[jk] * i2;
        __builtin_amdgcn_wave_barrier();
        float2 acc = make_float2(0.f, 0.f);
        for (int jk = 0; jk < nk; ++jk) {
            const float* vp = jk < nc ? F.cache_v + ((size_t)(b * 512 + jk) * 4 + h) * 128 : F.P + (size_t)(R0 + jk - nc) * PW + C_DV + h * 128;
            const float a = s1[jk]; const float2 v = *(const float2*)(vp + lane * 2);
            acc.x += a * v.x; acc.y += a * v.y;
        }
        *(float2*)(F.OD + (size_t)r * 512 + h * 128 + lane * 2) = acc;
        __builtin_amdgcn_wave_barrier();
    }
}


typedef short bf16x8 __attribute__((ext_vector_type(8)));
typedef float f32x16 __attribute__((ext_vector_type(16)));
typedef unsigned u32x4 __attribute__((ext_vector_type(4)));
typedef unsigned u32x2 __attribute__((ext_vector_type(2)));
#define MFMA32(a, b, c) __builtin_amdgcn_mfma_f32_32x32x16_bf16((a), (b), (c), 0, 0, 0)
__device__ __forceinline__ f32x16 zero16() { f32x16 z; _Pragma("unroll") for (int i = 0; i < 16; ++i) z[i] = 0.f; return z; }
typedef unsigned short bf16_t;
typedef float f32x4 __attribute__((ext_vector_type(4)));
__device__ __forceinline__ unsigned f2bf(float f) { unsigned u = __builtin_bit_cast(unsigned, f); return (u + 0x7fffu + ((u >> 16) & 1u)) >> 16; }
__device__ __forceinline__ unsigned pk2(float lo, float hi) { return f2bf(lo) | (f2bf(hi) << 16); }
__device__ __forceinline__ void st_bf16x4(bf16_t* p, f32x4 v) { uint2 w; w.x = pg8::cvt_pk_bf16(v[0], v[1]); w.y = pg8::cvt_pk_bf16(v[2], v[3]); *(uint2*)p = w; }
__device__ __forceinline__ int orig_col(int n) { return n < 1024 ? n : (n < 3584 ? n + 32 : (n < 3616 ? n - 3584 + 1024 : -1)); }

__device__ __forceinline__ void ph_prep(const Frame& F, LAS unsigned char* lds, bool do_mod) {
    const int tid = F.tid, lane = F.lane, wave = F.wave;
    if (do_mod) {
        LAS float* red = (LAS float*)lds;
        for (int item = F.bid; item < 256; item += F.G) {
            const int cg = item & 7, kg = item >> 3, k0 = kg * 32 + wave * 4;
            float acc[3][3][2];
#pragma unroll
            for (int v = 0; v < 3; ++v)
#pragma unroll
                for (int i = 0; i < 3; ++i) { acc[v][i][0] = 0.f; acc[v][i][1] = 0.f; }
#pragma unroll
            for (int kk = 0; kk < 4; ++kk) {
                const int k = k0 + kk;
                const float s0 = silu_f(F.c_ctx[k]), s1 = silu_f(F.c[k]), s2 = silu_f(F.c[D + k]);
#pragma unroll
                for (int i = 0; i < 3; ++i) {
                    const float2 w = *(const float2*)(F.w_mod + (size_t)k * 3072 + cg * 384 + i * 128 + lane * 2);
                    acc[0][i][0] += s0 * w.x; acc[0][i][1] += s0 * w.y; acc[1][i][0] += s1 * w.x; acc[1][i][1] += s1 * w.y; acc[2][i][0] += s2 * w.x; acc[2][i][1] += s2 * w.y;
                }
            }
#pragma unroll
            for (int v = 0; v < 3; ++v)
#pragma unroll
                for (int i = 0; i < 3; ++i) { red[(wave * 3 + v) * 384 + i * 128 + lane * 2] = acc[v][i][0]; red[(wave * 3 + v) * 384 + i * 128 + lane * 2 + 1] = acc[v][i][1]; }
            __syncthreads();
            for (int e = tid; e < 1152; e += NTHR) {
                const int v = e / 384, col = e - v * 384; float s = 0.f;
#pragma unroll
                for (int w = 0; w < 8; ++w) s += red[(w * 3 + v) * 384 + col];
                if (kg == 0) s += F.b_mod[cg * 384 + col];
                atomicAdd(&F.MOD[v * 3072 + cg * 384 + col], s);
            }
            __syncthreads();
        }
    }
    {
        LAS unsigned short* T = (LAS unsigned short*)lds;
        for (int t = F.bid; t < 1216; t += F.G) {
            const bool isin = t < 960; const int tt = isin ? t : t - 960; const int n0 = (tt >> 4) * 64, k0 = (tt & 15) * 64;
            const float* W = isin ? F.w_in : F.w_out; const int ldw = isin ? PW : D;
            {
                const int k = tid >> 3, n8 = (tid & 7) * 8; const int oc = isin ? orig_col(n0 + n8) : n0 + n8;
                float4 a = make_float4(0.f, 0.f, 0.f, 0.f), b = a;
                if (oc >= 0) { const float* p = W + (size_t)(k0 + k) * ldw + oc; a = *(const float4*)p; b = *(const float4*)(p + 4); }
                T[(n8 + 0) * 66 + k] = (unsigned short)f2bf(a.x); T[(n8 + 1) * 66 + k] = (unsigned short)f2bf(a.y); T[(n8 + 2) * 66 + k] = (unsigned short)f2bf(a.z); T[(n8 + 3) * 66 + k] = (unsigned short)f2bf(a.w);
                T[(n8 + 4) * 66 + k] = (unsigned short)f2bf(b.x); T[(n8 + 5) * 66 + k] = (unsigned short)f2bf(b.y); T[(n8 + 6) * 66 + k] = (unsigned short)f2bf(b.z); T[(n8 + 7) * 66 + k] = (unsigned short)f2bf(b.w);
            }
            __syncthreads();
            {
                const int n = tid >> 3, k8 = (tid & 7) * 8; const LAS unsigned* rp = (const LAS unsigned*)(T + n * 66 + k8);
                uint4 w; w.x = rp[0]; w.y = rp[1]; w.z = rp[2]; w.w = rp[3];
                bf16_t* dst = (isin ? F.WINT : F.WOT) + (size_t)(n0 + n) * D + k0 + k8;
                *(uint4*)dst = w;
            }
            __syncthreads();
        }
    }
    {
        for (int e8 = F.bid * NTHR + tid; e8 < 2 * 65536; e8 += F.G * NTHR) {
            const bool isv = e8 >= 65536; const int g = isv ? e8 - 65536 : e8; const int e = g * 8;
            const int b = e >> 18, rem = e & 262143, j = rem >> 9, c = rem & 511;
            const float* src = (isv ? F.cache_v : F.cache_k) + e;
            const float4 a = *(const float4*)src, bb = *(const float4*)(src + 4);
            uint4 w; w.x = pk2(a.x, a.y); w.y = pk2(a.z, a.w); w.z = pk2(bb.x, bb.y); w.w = pk2(bb.z, bb.w);
            *(uint4*)((isv ? F.DVS : F.DKS) + ((size_t)(b * 1536 + j) * 512 + c)) = w;
        }
    }
    {
        for (int idx = F.bid * NTHR + tid; idx < 1024; idx += F.G * NTHR) {
            const int pos = idx >> 4, i = idx & 15;
            const float ang = (float)pos * powf(10000.0f, -(float)i / 16.0f);
            F.ROPE[idx] = cosf(ang); F.ROPE[1024 + idx] = sinf(ang);
        }
        if (F.bid == 0 && tid < 64) {
            const float a = wave_sum(F.dlam[tid] * F.dlam[64 + tid]), b = wave_sum(F.dlam[128 + tid] * F.dlam[192 + tid]);
            if (tid == 0) F.ROPE[2048] = expf(a) - expf(b) + 0.2f;
        }
    }
}
constexpr int HB_LROW = 2064;
__device__ __forceinline__ void ph_hb(const Frame& F, LAS unsigned char* lds) {
    const int tid = F.tid, lane = tid & 63, wave = __builtin_amdgcn_readfirstlane(tid >> 6);
    for (int blk = F.bid; blk < NT / 24; blk += F.G) {
#pragma unroll 1
        for (int q = 0; q < 3; ++q) {
            const int rl = wave * 3 + q, r = blk * 24 + rl;
            const float* x = xrow(F, r); const float* m = F.MOD + variant_of(r) * 3072;
            float4 v[4]; float ss = 0.f;
#pragma unroll
            for (int i = 0; i < 4; ++i) { v[i] = *(const float4*)(x + i * 256 + lane * 4); ss += v[i].x * v[i].x + v[i].y * v[i].y + v[i].z * v[i].z + v[i].w * v[i].w; }
            ss = wave_sum(ss);
            const float rstd = 1.0f / sqrtf(ss * (1.0f / 1024.0f) + 1e-6f);
#pragma unroll
            for (int i = 0; i < 4; ++i) {
                const int k = i * 256 + lane * 4;
                const float4 g = *(const float4*)(F.norm_gain + k), sh = *(const float4*)(m + k), sc = *(const float4*)(m + 1024 + k);
                u32x2 w;
                w.x = pk2(v[i].x * rstd * g.x * (1.0f + sc.x) + sh.x, v[i].y * rstd * g.y * (1.0f + sc.y) + sh.y);
                w.y = pk2(v[i].z * rstd * g.z * (1.0f + sc.z) + sh.z, v[i].w * rstd * g.w * (1.0f + sc.w) + sh.w);
                *(u32x2*)(F.HB + (size_t)r * D + k) = w;
                *(LAS u32x2*)(lds + rl * HB_LROW + k * 2) = w;
            }
        }
        __syncthreads();
        {
            const int r = lane & 31, hh = lane >> 5;
            f32x16 acc = zero16();
#pragma unroll
            for (int ks = 0; ks < 8; ++ks) {
                const int k0 = wave * 128 + ks * 16 + hh * 8;
                bf16x8 a;
#pragma unroll
                for (int e = 0; e < 8; ++e) a[e] = 0;
                if (r < 24) a = *(const LAS bf16x8*)(lds + r * HB_LROW + k0 * 2);
                const bf16x8 bfr = *(const bf16x8*)(F.WINT + (size_t)(3584 + r) * D + k0);
                acc = MFMA32(a, bfr, acc);
            }
            LAS float* PL = (LAS float*)(lds + 24 * HB_LROW) + wave * 1024;
#pragma unroll
            for (int i = 0; i < 16; ++i) PL[i * 64 + lane] = acc[i];
        }
        __syncthreads();
#pragma unroll
        for (int q = 0; q < 2; ++q) {
            const int e = tid + 512 * q, i = e >> 6, ln = e & 63, row = (i & 3) + 8 * (i >> 2) + 4 * (ln >> 5), col = ln & 31;
            const LAS float* PL = (const LAS float*)(lds + 24 * HB_LROW);
            float s = 0.f;
#pragma unroll
            for (int w = 0; w < 8; ++w) s += PL[w * 1024 + e];
            if (row < 24) F.LR[(size_t)(blk * 24 + row) * 32 + col] = s;
        }
        __syncthreads();
    }
}
constexpr float QSCALE_DIFF = 0.125f * 1.4426950408889634f;
struct EpiInFast {
    static constexpr bool PERM = false, AFTER_DRAIN = false;
    bf16_t *QG, *KG, *VGT, *DQ, *DKP, *DVP, *DKS, *DVS, *SG; float* LR; float* out; const float* ROPE; float* P;
    __device__ __forceinline__ void operator()(const f32x4 (&acc)[2][2][4][2], const pg8::Unit& u, int wr, int wc, int fr, int fq) const {
        const int pn = u.pn; const bool samp = u.pm >= 16;
#pragma unroll
        for (int ai = 0; ai < 2; ++ai)
#pragma unroll
            for (int m = 0; m < 4; ++m) {
                const int row = u.pm * 256 + ai * 128 + wr * 64 + m * 16 + fr;
                const int ts = (row - NPR) & 1023, bs = (row - NPR) >> 10;
#pragma unroll
                for (int bj = 0; bj < 2; ++bj) {
                    f32x4 v0 = acc[ai][bj][m][0], v1 = acc[ai][bj][m][1];
                    const int cl = bj * 128 + wc * 32 + fq * 4;
                    if (pn == 0) { st_bf16x4(QG + (size_t)row * 256 + cl, v0 * 0.125f); st_bf16x4(QG + (size_t)row * 256 + cl + 16, v1 * 0.125f); }
                    else if (pn == 1) { st_bf16x4(KG + (size_t)row * 256 + cl, v0); st_bf16x4(KG + (size_t)row * 256 + cl + 16, v1); }
                    else if (pn < 4) {
                        bf16_t* d = VGT + (size_t)((pn - 2) * 256 + cl) * NT + row;
#pragma unroll
                        for (int e = 0; e < 4; ++e) { d[(size_t)e * NT] = (bf16_t)f2bf(v0[e]); d[(size_t)(16 + e) * NT] = (bf16_t)f2bf(v1[e]); }
                    }
                    else if (pn < 8) {
                        const bool isk = pn >= 6; const int c512 = (pn - (isk ? 6 : 4)) * 256 + cl;
                        if (samp) {
                            const int pos = (wc & 1) ? (ts & 63) : (ts >> 6);
                            const f32x4 cs = *(const f32x4*)(ROPE + pos * 16 + fq * 4), sn = *(const f32x4*)(ROPE + 1024 + pos * 16 + fq * 4);
                            const f32x4 r0 = v0 * cs - v1 * sn, r1 = v0 * sn + v1 * cs; v0 = r0; v1 = r1;
                        }
                        if (!isk) { bf16_t* d = DQ + (size_t)row * 512 + c512; st_bf16x4(d, v0 * QSCALE_DIFF); st_bf16x4(d + 16, v1 * QSCALE_DIFF); }
                        else if (!samp) { float* o = out + O_NK + (size_t)row * 512 + c512; *(f32x4*)o = v0; *(f32x4*)(o + 16) = v1; bf16_t* d = DKP + (size_t)row * 512 + c512; st_bf16x4(d, v0); st_bf16x4(d + 16, v1); }
                        else { bf16_t* d = DKS + ((size_t)(bs * 1536 + 512 + ts)) * 512 + c512; st_bf16x4(d, v0); st_bf16x4(d + 16, v1); }
                    }
                    else if (pn < 10) {
                        const int c512 = (pn - 8) * 256 + cl;
                        if (!samp) { float* o = out + O_NV + (size_t)row * 512 + c512; *(f32x4*)o = v0; *(f32x4*)(o + 16) = v1; bf16_t* d = DVP + (size_t)row * 512 + c512; st_bf16x4(d, v0); st_bf16x4(d + 16, v1); }
                        else { bf16_t* d = DVS + ((size_t)(bs * 1536 + 512 + ts)) * 512 + c512; st_bf16x4(d, v0); st_bf16x4(d + 16, v1); }
                    }
                    else if (pn < 14) {
                        bf16_t* d = SG + (size_t)row * 1024 + (pn - 10) * 256 + cl;
                        f32x4 s0, s1;
#pragma unroll
                        for (int j = 0; j < 4; ++j) { s0[j] = v0[j] / (1.0f + __expf(-v0[j])); s1[j] = v1[j] / (1.0f + __expf(-v1[j])); }
                        st_bf16x4(d, s0); st_bf16x4(d + 16, s1);
                    }
                    else { if (bj == 0 && wc == 0) { float* o = LR + (size_t)row * 32 + fq * 4; *(f32x4*)o = v0; *(f32x4*)(o + 16) = v1; } }
                    if (P) {
                        const int n0 = pn * 256 + cl; const int oc = orig_col(n0);
                        if (oc >= 0) { *(f32x4*)(P + (size_t)row * PW + oc) = v0; *(f32x4*)(P + (size_t)row * PW + oc + 16) = v1; }
                    }
                }
            }
    }
};


struct EpiOutFast {
    static constexpr bool PERM = false, AFTER_DRAIN = false;
    const float* x_prompt; const float* x_sample; const float* MOD; float* out;
    __device__ __forceinline__ void operator()(const f32x4 (&acc)[2][2][4][2], const pg8::Unit& u, int wr, int wc, int fr, int fq) const {
        const float* gt = MOD + (u.pm < 16 ? 0 : (u.pm < 20 ? 1 : 2)) * 3072 + 2048;
#pragma unroll
        for (int ai = 0; ai < 2; ++ai)
#pragma unroll
            for (int m = 0; m < 4; ++m) {
                const int row = u.pm * 256 + ai * 128 + wr * 64 + m * 16 + fr;
                const float* xr = row < NPR ? x_prompt + (size_t)row * D : x_sample + (size_t)(row - NPR) * D;
#pragma unroll
                for (int bj = 0; bj < 2; ++bj)
#pragma unroll
                    for (int n = 0; n < 2; ++n) {
                        const int col = u.pn * 256 + bj * 128 + wc * 32 + n * 16 + fq * 4;
                        const f32x4 xv = *(const f32x4*)(xr + col), g4 = *(const f32x4*)(gt + col);
                        *(f32x4*)(out + (size_t)row * D + col) = xv + g4 * acc[ai][bj][m][n];
                    }
            }
    }
};


typedef short s16x4 __attribute__((ext_vector_type(4)));
typedef __bf16 bf16x8_t __attribute__((ext_vector_type(8)));
typedef float f32x8 __attribute__((ext_vector_type(8)));
__device__ __forceinline__ bf16x8 pack8(f32x8 v) { return __builtin_bit_cast(bf16x8, __builtin_convertvector(v, bf16x8_t)); }
__device__ __forceinline__ float bf2f(unsigned short u) { return __builtin_bit_cast(float, (unsigned)u << 16); }
__device__ __forceinline__ bf16x8 tr8(const LAS unsigned char* p0, const LAS unsigned char* p1) {
    const s16x4 lo = __builtin_amdgcn_ds_read_tr16_b64_v4i16((LAS s16x4*)p0), hi = __builtin_amdgcn_ds_read_tr16_b64_v4i16((LAS s16x4*)p1);
    return __builtin_shufflevector(lo, hi, 0, 1, 2, 3, 4, 5, 6, 7);
}
constexpr int AT_KROW = 272, AT_VROW = 320, AT_KBYTES = 64 * AT_KROW, AT_STAGE = AT_KBYTES + 64 * AT_VROW;
constexpr int AT_EXROW = 129;

template <int VAR>
__device__ __forceinline__ void attn_item(const Frame& F, LAS unsigned char* lds, int grp, int b, int h, int qblk, float lam, int kh, int pairid) {
    int tid = F.tid; asm volatile("" : "+v"(tid));
    const int lane = tid & 63, wave = __builtin_amdgcn_readfirstlane(tid >> 6), rg = wave & 3, map = wave >> 2, r = lane & 31, hh = lane >> 5;
    const int R0 = grp == 0 ? b * 256 : NPR + b * 1024, nk = grp == 0 ? 256 : 1536;
    const size_t kvoff = (size_t)(b * nk) * 512 + h * 128;
    const bf16_t* Kb = (const bf16_t*)(F.ws + (grp == 0 ? WS_DKP : WS_DKS)) + kvoff;
    const bf16_t* Vb = (const bf16_t*)(F.ws + (grp == 0 ? WS_DVP : WS_DVS)) + kvoff;
    const int qrow = R0 + qblk * 128 + rg * 32 + r;
    bf16x8 qf[4];
#pragma unroll
    for (int ks = 0; ks < 4; ++ks) qf[ks] = *(const bf16x8*)(F.DQ + (size_t)qrow * 512 + h * 128 + map * 64 + ks * 16 + hh * 8);
    f32x16 O[4];
#pragma unroll
    for (int jt = 0; jt < 4; ++jt)
#pragma unroll
        for (int i = 0; i < 16; ++i) O[jt][i] = 0.f;
    float m_run = -1.0e30f, l_run = 0.f;
    const int ntall = nk >> 6, t0 = kh < 0 ? 0 : kh * (ntall >> 1), nt = kh < 0 ? ntall : t0 + (ntall >> 1);
    const int srow0 = tid >> 4, sch = tid & 15;
    u32x4 stg[4];
#define AT_LOAD(t) do { _Pragma("unroll") for (int i = 0; i < 2; ++i) { \
        stg[i]     = *(const u32x4*)(Kb + (size_t)((t) * 64 + srow0 + 32 * i) * 512 + sch * 8); \
        stg[2 + i] = *(const u32x4*)(Vb + (size_t)((t) * 64 + srow0 + 32 * i) * 512 + sch * 8); } } while (0)
#define AT_WRITE(buf) do { _Pragma("unroll") for (int i = 0; i < 2; ++i) { \
        *(LAS u32x4*)(lds + (buf) * AT_STAGE + (srow0 + 32 * i) * AT_KROW + sch * 16) = stg[i]; \
        *(LAS u32x4*)(lds + (buf) * AT_STAGE + AT_KBYTES + (srow0 + 32 * i) * AT_VROW + sch * 16) = stg[2 + i]; } } while (0)
    const int koff = r * AT_KROW + map * 128 + hh * 16;
    const int voff = AT_KBYTES + (4 * hh + ((lane & 15) >> 2)) * AT_VROW + (16 * ((lane >> 4) & 1) + 4 * (lane & 3)) * 2;
    AT_LOAD(t0); AT_WRITE(t0 & 1);
    __syncthreads();
    for (int t = t0; t < nt; ++t) {
        const int buf = (VAR & 1) ? (t0 & 1) : (t & 1);
        if (!(VAR & 1)) { if (t + 1 < nt) AT_LOAD(t + 1); }
        const LAS unsigned char* sb = lds + buf * AT_STAGE;
        f32x16 S[2];
#pragma unroll
        for (int sub = 0; sub < 2; ++sub) {
#pragma unroll
            for (int i = 0; i < 16; ++i) S[sub][i] = 0.f;
#pragma unroll
            for (int ks = 0; ks < 4; ++ks) {
                const bf16x8 kf = *(const LAS bf16x8*)(sb + koff + sub * 32 * AT_KROW + ks * 32);
                if (!(VAR & 8)) S[sub] = MFMA32(kf, qf[ks], S[sub]); else asm volatile("" :: "v"(kf));
            }
        }
        bf16x8 pb[2][2];
        if (!(VAR & 2)) {
        float mx = S[0][0];
#pragma unroll
        for (int i = 1; i < 16; ++i) mx = fmaxf(mx, S[0][i]);
#pragma unroll
        for (int i = 0; i < 16; ++i) mx = fmaxf(mx, S[1][i]);
        mx = fmaxf(mx, __shfl_xor(mx, 32));
        const float m_new = fmaxf(m_run, mx), alpha = __builtin_amdgcn_exp2f(m_run - m_new);
        m_run = m_new; l_run *= alpha;
#pragma unroll
        for (int jt = 0; jt < 4; ++jt) O[jt] = O[jt] * alpha;
#pragma unroll
        for (int sub = 0; sub < 2; ++sub) {
            f32x8 p0, p1;
#pragma unroll
            for (int i = 0; i < 8; ++i) { p0[i] = __builtin_amdgcn_exp2f(S[sub][i] - m_new); p1[i] = __builtin_amdgcn_exp2f(S[sub][8 + i] - m_new); l_run += p0[i] + p1[i]; }
            pb[sub][0] = pack8(p0); pb[sub][1] = pack8(p1);
        }
        } else {
#pragma unroll
            for (int sub = 0; sub < 2; ++sub) { f32x8 p0, p1; _Pragma("unroll") for (int i = 0; i < 8; ++i) { p0[i] = S[sub][i]; p1[i] = S[sub][8 + i]; } pb[sub][0] = pack8(p0); pb[sub][1] = pack8(p1); l_run += S[sub][0]; }
        }
#pragma unroll
        for (int sub = 0; sub < 2; ++sub)
#pragma unroll
            for (int s = 0; s < 2; ++s)
#pragma unroll
                for (int jt = 0; jt < 4; ++jt) {
                    const LAS unsigned char* vp = sb + voff + (32 * sub + 16 * s) * AT_VROW + jt * 64;
                    const bf16x8 vf = tr8(vp, vp + 8 * AT_VROW);
                    if (!(VAR & 4)) O[jt] = MFMA32(vf, pb[sub][s], O[jt]); else asm volatile("" :: "v"(vf), "v"(pb[sub][s]));
                }
        if (!(VAR & 1)) { if (t + 1 < nt) AT_WRITE(buf ^ 1); }
        __syncthreads();
    }
#undef AT_LOAD
#undef AT_WRITE
    if (kh >= 0) {
        float* PO = (float*)(F.ws + WS_ATP) + ((size_t)(pairid * 2 + kh) * 8 + wave) * (66 * 64);
#pragma unroll
        for (int jt = 0; jt < 4; ++jt)
#pragma unroll
            for (int i = 0; i < 16; ++i) PO[(jt * 16 + i) * 64 + lane] = O[jt][i];
        PO[64 * 64 + lane] = m_run; PO[65 * 64 + lane] = l_run;
        asm volatile("s_waitcnt vmcnt(0)" ::: "memory"); __syncthreads();
        volatile LAS unsigned* flagw = (volatile LAS unsigned*)(lds + LDS_BYTES - 64 + 16);
        if (tid == 0) {
            __builtin_amdgcn_fence(__ATOMIC_RELEASE, "agent");
            asm volatile("s_waitcnt vmcnt(0)" ::: "memory");
            const unsigned old = __hip_atomic_fetch_add((unsigned*)(F.ws + WS_ATCNT) + 16 * pairid, 1u, __ATOMIC_RELAXED, __HIP_MEMORY_SCOPE_AGENT);
            if (old == 1u) { __builtin_amdgcn_fence(__ATOMIC_ACQUIRE, "agent"); asm volatile("s_waitcnt vmcnt(0)" ::: "memory"); }
            flagw[0] = old;
        }
        __syncthreads();
        const unsigned old = flagw[0];
        __syncthreads();
        if (old != 1u) return;
        const float* QO = (const float*)(F.ws + WS_ATP) + ((size_t)(pairid * 2 + (kh ^ 1)) * 8 + wave) * (66 * 64);
        const float m_b = QO[64 * 64 + lane], l_b = QO[65 * 64 + lane];
        const float m_new = fmaxf(m_run, m_b), sa = __builtin_amdgcn_exp2f(m_run - m_new), sb = __builtin_amdgcn_exp2f(m_b - m_new);
        l_run = l_run * sa + l_b * sb; m_run = m_new;
#pragma unroll
        for (int jt = 0; jt < 4; ++jt)
#pragma unroll
            for (int i = 0; i < 16; ++i) O[jt][i] = O[jt][i] * sa + QO[(jt * 16 + i) * 64 + lane] * sb;
    }
    const float l_tot = l_run + __shfl_xor(l_run, 32), inv = 1.0f / l_tot;
    LAS float* EX = (LAS float*)lds;
    {
        LAS float* ex = EX + (map * 128 + rg * 32 + r) * AT_EXROW;
#pragma unroll
        for (int jt = 0; jt < 4; ++jt)
#pragma unroll
            for (int i = 0; i < 16; ++i) ex[32 * jt + (i & 3) + 8 * (i >> 2) + 4 * hh] = O[jt][i] * inv;
    }
    __syncthreads();
    {
        const int ql = tid >> 2, part = tid & 3; const int row = R0 + qblk * 128 + ql;
        const LAS float* e0 = EX + ql * AT_EXROW + part * 32; const LAS float* e1 = e0 + 128 * AT_EXROW;
        float o[32]; float ss = 0.f;
#pragma unroll
        for (int j = 0; j < 32; ++j) { o[j] = e0[j] - lam * e1[j]; ss += o[j] * o[j]; }
        ss += __shfl_xor(ss, 1); ss += __shfl_xor(ss, 2);
        const float rstd = 0.8f / sqrtf(ss * (1.0f / 128.0f) + 1e-6f);
        const bf16_t* sg = F.SG + (size_t)row * 1024 + 512 + h * 128 + part * 32;
        bf16_t* dst = F.MGB + (size_t)row * 1024 + 512 + h * 128 + part * 32;
        const float* gain = F.diff_gain + part * 32;
#pragma unroll
        for (int c = 0; c < 4; ++c) {
            const uint4 gw = *(const uint4*)(sg + c * 8); const unsigned gws[4] = {gw.x, gw.y, gw.z, gw.w};
            unsigned w[4];
#pragma unroll
            for (int e = 0; e < 4; ++e) {
                const int j = c * 8 + e * 2;
                const float a0 = o[j] * rstd * gain[j] * bf2f((unsigned short)(gws[e] & 0xffffu)), a1 = o[j + 1] * rstd * gain[j + 1] * bf2f((unsigned short)(gws[e] >> 16));
                w[e] = pk2(a0, a1);
            }
            *(uint4*)(dst + c * 8) = make_uint4(w[0], w[1], w[2], w[3]);
        }
    }
    __syncthreads();
}

constexpr int GU_DS = 0, GU_SC = 32768, GU_QF = 49152, GU_KF = 57344, GU_BL = 65536, GU_BYTES = 67584;
constexpr int GW_R1 = 0, GW_R2 = 9216, GW_BYTES = 14336;
constexpr int GV_ROW = 136, GT_ROW = 80, GO_ROW = 272;
constexpr float LOG2E = 1.4426950408889634f;
__device__ __forceinline__ int crow(int i, int hh) { return (i & 3) + 8 * (i >> 2) + 4 * hh; }
__device__ __forceinline__ void split8(const float (&x)[8], bf16x8& hi, bf16x8& lo) {
    f32x8 v, w;
#pragma unroll
    for (int i = 0; i < 8; ++i) v[i] = x[i];
    const bf16x8_t h = __builtin_convertvector(v, bf16x8_t);
    const f32x8 hf = __builtin_convertvector(h, f32x8);
#pragma unroll
    for (int i = 0; i < 8; ++i) w[i] = x[i] - hf[i];
    hi = __builtin_bit_cast(bf16x8, h); lo = pack8(w);
}
__device__ __forceinline__ s16x4 rev4(s16x4 v) { return __builtin_shufflevector(v, v, 3, 2, 1, 0); }

struct GSeq { int R0, n, nc, dir, h, b, grp, ubase; };
__device__ __forceinline__ GSeq gseq_decode(int sq) {
    GSeq s;
    if (sq < 16) { s.grp = 1; s.b = sq >> 3; s.h = (sq >> 1) & 3; s.dir = sq & 1; s.R0 = NPR + s.b * 1024; s.n = 1024; s.nc = 16; s.ubase = sq * 16; }
    else { const int p = sq - 16; s.grp = 0; s.b = p >> 3; s.h = (p >> 1) & 3; s.dir = p & 1; s.R0 = s.b * 256; s.n = 256; s.nc = 4; s.ubase = 256 + p * 4; }
    return s;
}
__device__ __forceinline__ int gseq_row(const GSeq& s, int tau) { return s.R0 + (s.dir ? s.n - 1 - tau : tau); }
__device__ __forceinline__ bf16x8 g2_vfrag(const LAS unsigned char* R1, int dir, int jl, int st, int sp, int r, int hh) {
    const LAS unsigned char* row = R1 + (32 * jl + r) * GV_ROW;
    const int base = 32 * st + 16 * sp + 4 * hh;
    s16x4 lo, hi;
    if (dir == 0) { lo = *(const LAS s16x4*)(row + base * 2); hi = *(const LAS s16x4*)(row + (base + 8) * 2); }
    else { lo = rev4(*(const LAS s16x4*)(row + (60 - base) * 2)); hi = rev4(*(const LAS s16x4*)(row + (52 - base) * 2)); }
    return __builtin_shufflevector(lo, hi, 0, 1, 2, 3, 4, 5, 6, 7);
}
__device__ __forceinline__ void g2_load_vt(const Frame& F, LAS unsigned char* R1, int h, int half, int tbase, int lane) {
#pragma unroll
    for (int i = 0; i < 8; ++i) {
        const int jl = 8 * i + (lane >> 3), ch = lane & 7;
        const u32x2* src = (const u32x2*)(F.VGT + (size_t)(h * 128 + 64 * half + jl) * NT + tbase + ch * 8);
        const u32x2 a = src[0], b = src[1];
        *(LAS u32x2*)(R1 + jl * GV_ROW + ch * 16) = a; *(LAS u32x2*)(R1 + jl * GV_ROW + ch * 16 + 8) = b;
    }
}

__device__ __forceinline__ void gla1_unit(const Frame& F, LAS unsigned char* wl, int u, int lane0) {
    int lane = lane0; asm volatile("" : "+v"(lane));
    const GSeq s = gseq_decode(u < 256 ? (u >> 4) : 16 + ((u - 256) >> 2));
    const int c = u < 256 ? (u & 15) : ((u - 256) & 3);
    const int h = s.h, dir = s.dir;
    unsigned char* blk = F.GSC + (size_t)u * GU_BYTES;
    LAS unsigned char* R1 = wl + GW_R1; LAS unsigned char* R2 = wl + GW_R2;
    const int tbase = s.R0 + (dir ? s.n - 64 - 64 * c : 64 * c);
#pragma unroll 1
    for (int kt = 0; kt < 2; ++kt) {
        int ln = lane; asm volatile("" : "+v"(ln));
        const int r = ln & 31, hh = ln >> 5;
        u32x4 kreg[4], qreg[4]; u32x2 vreg[16];
#pragma unroll
        for (int i = 0; i < 4; ++i) {
            const int tl = 16 * i + (ln >> 2), ch = ln & 3; const size_t ro = (size_t)gseq_row(s, 64 * c + tl) * 256 + h * 64 + 32 * kt + ch * 8;
            kreg[i] = *(const u32x4*)(F.KG + ro); qreg[i] = *(const u32x4*)(F.QG + ro);
        }
#pragma unroll
        for (int i = 0; i < 8; ++i) {
            const int jl = 8 * i + (ln >> 3), ch = ln & 7; const u32x2* sp = (const u32x2*)(F.VGT + (size_t)(h * 128 + jl) * NT + tbase + ch * 8);
            vreg[2 * i] = sp[0]; vreg[2 * i + 1] = sp[1];
        }
        float w[8], lx[2][8];
#pragma unroll
        for (int jj = 0; jj < 8; ++jj) w[jj] = F.w_alpha[(size_t)(dir * 16 + 8 * hh + jj) * 256 + h * 64 + 32 * kt + r];
        const float bias = F.b_alpha[dir * 256 + h * 64 + 32 * kt + r];
#pragma unroll
        for (int tt = 0; tt < 2; ++tt) {
            const float* lp = F.LR + (size_t)gseq_row(s, 64 * c + 32 * tt + r) * 32 + dir * 16 + 8 * hh;
            const float4 l0 = *(const float4*)lp, l1 = *(const float4*)(lp + 4);
            lx[tt][0] = l0.x; lx[tt][1] = l0.y; lx[tt][2] = l0.z; lx[tt][3] = l0.w; lx[tt][4] = l1.x; lx[tt][5] = l1.y; lx[tt][6] = l1.z; lx[tt][7] = l1.w;
        }
        bf16x8 Ltri[2], Lone, Iden[2];
#pragma unroll
        for (int jj = 0; jj < 8; ++jj) Lone[jj] = (short)0x3F80;
#pragma unroll
        for (int sp = 0; sp < 2; ++sp)
#pragma unroll
            for (int jj = 0; jj < 8; ++jj) {
                const int sx = 16 * sp + 8 * (jj >> 2) + 4 * hh + (jj & 3); Ltri[sp][jj] = (sx <= r) ? (short)0x3F80 : (short)0;
                Iden[sp][jj] = (16 * sp + 8 * hh + jj == r) ? (short)0x3F80 : (short)0;
            }
        bf16x8 whi, wlo; split8(w, whi, wlo);
        bf16x8 ghi[2][2], glo[2][2];
#pragma unroll
        for (int tt = 0; tt < 2; ++tt) {
            bf16x8 ahi, alo; split8(lx[tt], ahi, alo);
            f32x16 z = MFMA32(ahi, whi, zero16()); z = MFMA32(alo, whi, z); z = MFMA32(ahi, wlo, z);
            float gv[16];
#pragma unroll
            for (int i = 0; i < 16; ++i) {
                const float zz = z[i] + bias;
                const float sp = __builtin_amdgcn_logf(1.0f + __builtin_amdgcn_exp2f(-fabsf(zz) * LOG2E)) * 0.6931471805599453f;
                gv[i] = (fminf(zz, 0.f) - sp) * 0.0625f;
            }
#pragma unroll
            for (int sp = 0; sp < 2; ++sp) { float x[8]; _Pragma("unroll") for (int jj = 0; jj < 8; ++jj) x[jj] = gv[8 * sp + jj]; split8(x, ghi[tt][sp], glo[tt][sp]); }
        }
        f32x16 bb[2];
        {
            f32x16 a = zero16(), d = zero16();
#pragma unroll
            for (int sp = 0; sp < 2; ++sp) { a = MFMA32(Ltri[sp], ghi[0][sp], a); a = MFMA32(Ltri[sp], glo[0][sp], a); }
#pragma unroll
            for (int sp = 0; sp < 2; ++sp) { d = MFMA32(Lone, ghi[0][sp], d); d = MFMA32(Lone, glo[0][sp], d); d = MFMA32(Ltri[sp], ghi[1][sp], d); d = MFMA32(Ltri[sp], glo[1][sp], d); }
            bb[0] = a; bb[1] = d;
        }
        float blast;
        { const float x = bb[1][15]; const float y = __shfl_xor(x, 32); blast = hh ? x : y; }
        if (hh == 0) ((float*)(blk + GU_BL))[32 * kt + r] = blast;
#pragma unroll
        for (int i = 0; i < 4; ++i) { const int tl = 16 * i + (ln >> 2), ch = ln & 3; *(LAS u32x4*)(R2 + tl * GT_ROW + ch * 16) = kreg[i]; }
        bf16x8 khat[2][2];
#pragma unroll
        for (int st = 0; st < 2; ++st) {
            const LAS unsigned char* kp = R2 + (32 * st + r) * GT_ROW + 8 * hh * 2;
            f32x16 ka = MFMA32(*(const LAS bf16x8*)(kp), Iden[0], zero16()); ka = MFMA32(*(const LAS bf16x8*)(kp + 32), Iden[1], ka);
            float kh[16];
#pragma unroll
            for (int i = 0; i < 16; ++i) {
                const float bv = bb[st][i];
                kh[i] = ka[i] * __builtin_amdgcn_exp2f((blast - bv) * LOG2E);
                *(LAS unsigned short*)(R1 + (32 * st + crow(i, hh)) * GT_ROW + r * 2) = (unsigned short)f2bf(ka[i] * __builtin_amdgcn_exp2f(-bv * LOG2E));
            }
#pragma unroll
            for (int sp = 0; sp < 2; ++sp) { f32x8 x; _Pragma("unroll") for (int jj = 0; jj < 8; ++jj) x[jj] = kh[8 * sp + jj]; khat[st][sp] = pack8(x); }
        }
        {
            bf16_t* KF = (bf16_t*)(blk + GU_KF);
#pragma unroll
            for (int st = 0; st < 2; ++st)
#pragma unroll
                for (int ksl = 0; ksl < 2; ++ksl)
                    *(u32x4*)(KF + ((((st * 4 + 2 * kt + ksl) * 2 + hh) * 32 + r) * 8)) = *(const LAS u32x4*)(R1 + (32 * st + r) * GT_ROW + (16 * ksl + 8 * hh) * 2);
        }
#pragma unroll
        for (int i = 0; i < 4; ++i) { const int tl = 16 * i + (ln >> 2), ch = ln & 3; *(LAS u32x4*)(R2 + tl * GT_ROW + ch * 16) = qreg[i]; }
#pragma unroll
        for (int tt = 0; tt < 2; ++tt) {
            const LAS unsigned char* qp = R2 + (32 * tt + r) * GT_ROW + 8 * hh * 2;
            f32x16 qa = MFMA32(*(const LAS bf16x8*)(qp), Iden[0], zero16()); qa = MFMA32(*(const LAS bf16x8*)(qp + 32), Iden[1], qa);
#pragma unroll
            for (int i = 0; i < 16; ++i)
                *(LAS unsigned short*)(R1 + (32 * tt + crow(i, hh)) * GT_ROW + r * 2) = (unsigned short)f2bf(qa[i] * __builtin_amdgcn_exp2f(bb[tt][i] * LOG2E));
        }
        {
            bf16_t* QF = (bf16_t*)(blk + GU_QF);
#pragma unroll
            for (int tt = 0; tt < 2; ++tt)
#pragma unroll
                for (int ksl = 0; ksl < 2; ++ksl)
                    *(u32x4*)(QF + ((((tt * 4 + 2 * kt + ksl) * 2 + hh) * 32 + r) * 8)) = *(const LAS u32x4*)(R1 + (32 * tt + r) * GT_ROW + (16 * ksl + 8 * hh) * 2);
        }
        float* DS = (float*)(blk + GU_DS);
#pragma unroll
        for (int half = 0; half < 2; ++half) {
#pragma unroll
            for (int i = 0; i < 8; ++i) { const int jl = 8 * i + (ln >> 3), ch = ln & 7; *(LAS u32x2*)(R1 + jl * GV_ROW + ch * 16) = vreg[2 * i]; *(LAS u32x2*)(R1 + jl * GV_ROW + ch * 16 + 8) = vreg[2 * i + 1]; }
            if (half == 0) {
#pragma unroll
                for (int i = 0; i < 8; ++i) {
                    const int jl = 8 * i + (ln >> 3), ch = ln & 7; const u32x2* sp = (const u32x2*)(F.VGT + (size_t)(h * 128 + 64 + jl) * NT + tbase + ch * 8);
                    vreg[2 * i] = sp[0]; vreg[2 * i + 1] = sp[1];
                }
            }
#pragma unroll
            for (int jl = 0; jl < 2; ++jl) {
                f32x16 d0 = zero16();
#pragma unroll
                for (int st = 0; st < 2; ++st)
#pragma unroll
                    for (int sp = 0; sp < 2; ++sp) d0 = MFMA32(g2_vfrag(R1, dir, jl, st, sp, r, hh), khat[st][sp], d0);
                const int jt = 2 * half + jl;
#pragma unroll
                for (int i = 0; i < 16; ++i) DS[((jt * 2 + kt) * 16 + i) * 64 + ln] = d0[i];
            }
        }
    }
}

__device__ __forceinline__ void gla2_scan(const Frame& F, int sq, int tid0) {
    int tid = tid0; asm volatile("" : "+v"(tid));
    const GSeq s = gseq_decode(sq);
    float S[2][8];
#pragma unroll
    for (int q = 0; q < 2; ++q) {
        const int p = tid + 512 * q, j = p >> 3, k8 = (p & 7) * 8;
        if (s.grp == 0) { _Pragma("unroll") for (int e = 0; e < 8; ++e) S[q][e] = 0.f; }
        else { const float* st = (s.dir == 0 ? F.st_f : F.st_b) + (size_t)(s.b * 4 + s.h) * 8192; _Pragma("unroll") for (int e = 0; e < 8; ++e) S[q][e] = st[(k8 + e) * 128 + j]; }
    }
    for (int c0 = 0; c0 < s.nc; c0 += 4) {
        float4 dv[4][2][2], bv[4][2][2];
#pragma unroll
        for (int cc = 0; cc < 4; ++cc) {
            const unsigned char* blk = F.GSC + (size_t)(s.ubase + c0 + cc) * GU_BYTES;
            const float* DS = (const float*)(blk + GU_DS); const float* BL = (const float*)(blk + GU_BL);
#pragma unroll
            for (int q = 0; q < 2; ++q) {
                const int p = tid + 512 * q, j = p >> 3, k8 = (p & 7) * 8;
                const int jt = j >> 5, jr = j & 31, jhh = (jr >> 2) & 1, ji = (jr & 3) + 4 * (jr >> 3), kt = k8 >> 5;
                const float* dp = DS + ((jt * 2 + kt) * 16 + ji) * 64 + jhh * 32 + (k8 & 31);
                dv[cc][q][0] = *(const float4*)dp; dv[cc][q][1] = *(const float4*)(dp + 4); bv[cc][q][0] = *(const float4*)(BL + k8); bv[cc][q][1] = *(const float4*)(BL + k8 + 4);
            }
        }
#pragma unroll
        for (int cc = 0; cc < 4; ++cc) {
            bf16_t* SC = (bf16_t*)(F.GSC + (size_t)(s.ubase + c0 + cc) * GU_BYTES + GU_SC);
#pragma unroll
            for (int q = 0; q < 2; ++q) {
                const int p = tid + 512 * q, j = p >> 3, k8 = (p & 7) * 8;
                const int jt = j >> 5, jr = j & 31, ks = k8 >> 4, khh = (k8 >> 3) & 1;
                u32x4 w; w.x = pk2(S[q][0], S[q][1]); w.y = pk2(S[q][2], S[q][3]); w.z = pk2(S[q][4], S[q][5]); w.w = pk2(S[q][6], S[q][7]);
                *(u32x4*)(SC + ((((jt * 4 + ks) * 2 + khh) * 32 + jr) * 8)) = w;
                const float4 d0 = dv[cc][q][0], d1 = dv[cc][q][1], b0 = bv[cc][q][0], b1 = bv[cc][q][1];
                const float dd[8] = {d0.x, d0.y, d0.z, d0.w, d1.x, d1.y, d1.z, d1.w}, bl[8] = {b0.x, b0.y, b0.z, b0.w, b1.x, b1.y, b1.z, b1.w};
#pragma unroll
                for (int e = 0; e < 8; ++e) S[q][e] = __builtin_amdgcn_exp2f(bl[e] * LOG2E) * S[q][e] + dd[e];
            }
        }
    }
    if (s.grp == 0) {
        float* so = F.out + (s.dir == 0 ? O_SF : O_SB) + (size_t)(s.b * 4 + s.h) * 8192;
#pragma unroll
        for (int q = 0; q < 2; ++q) { const int p = tid + 512 * q, j = p >> 3, k8 = (p & 7) * 8; _Pragma("unroll") for (int e = 0; e < 8; ++e) so[(k8 + e) * 128 + j] = S[q][e]; }
    }
}

constexpr int G3_EX = 8 * GW_R2;
__device__ __forceinline__ void gla3_slot(const Frame& F, LAS unsigned char* lds, int slot, int tid0) {
    int tid = tid0; asm volatile("" : "+v"(tid));
    const int lane = tid & 63, wave = __builtin_amdgcn_readfirstlane(tid >> 6), d = wave & 1, pair = wave >> 1;
    const int w3 = slot * 4 + pair, ttn = w3 & 1, cu = w3 >> 1;
    int grp, b, h, c, nc, R0;
    if (cu < 128) { grp = 1; b = cu >> 6; h = (cu >> 4) & 3; c = cu & 15; nc = 16; R0 = NPR + b * 1024; } else { const int cp = cu - 128; grp = 0; b = cp >> 4; h = (cp >> 2) & 3; c = cp & 3; nc = 4; R0 = b * 256; }
    const int sq = (grp ? (b * 4 + h) * 2 : 16 + (b * 4 + h) * 2) + d;
    const int ub = grp ? sq * 16 : 256 + (sq - 16) * 4;
    LAS unsigned char* R1 = lds + wave * GW_R2;
    LAS float* EX = (LAS float*)(lds + G3_EX + pair * 16384);
    const int r = lane & 31, hh = lane >> 5;
    f32x16 o[4];
#pragma unroll
    for (int jt = 0; jt < 4; ++jt) o[jt] = zero16();
    bf16x8 pa[2][2];
    const int ttd = d ? 1 - ttn : ttn, rr = d ? 31 - r : r;
    {
        const unsigned char* blk = F.GSC + (size_t)(ub + (d ? nc - 1 - c : c)) * GU_BYTES;
        const bf16_t* QF = (const bf16_t*)(blk + GU_QF); const bf16_t* KF = (const bf16_t*)(blk + GU_KF); const bf16_t* SC = (const bf16_t*)(blk + GU_SC);
        bf16x8 qf[4];
#pragma unroll
        for (int ks = 0; ks < 4; ++ks) qf[ks] = *(const bf16x8*)(QF + ((((ttd * 4 + ks) * 2 + hh) * 32 + rr) * 8));
#pragma unroll
        for (int jt = 0; jt < 4; ++jt) {
#pragma unroll
            for (int ks = 0; ks < 4; ++ks) o[jt] = MFMA32(*(const bf16x8*)(SC + ((((jt * 4 + ks) * 2 + hh) * 32 + r) * 8)), qf[ks], o[jt]);
        }
#pragma unroll
        for (int st = 0; st < 2; ++st) {
            f32x16 at = zero16();
            if (st <= ttd) {
#pragma unroll
                for (int ks = 0; ks < 4; ++ks) at = MFMA32(*(const bf16x8*)(KF + ((((st * 4 + ks) * 2 + hh) * 32 + r) * 8)), qf[ks], at);
            }
#pragma unroll
            for (int sp = 0; sp < 2; ++sp) {
                f32x8 x;
#pragma unroll
                for (int jj = 0; jj < 8; ++jj) { const int i = 8 * sp + jj; x[jj] = (st < ttd || crow(i, hh) <= rr) ? at[i] : 0.f; }
                pa[st][sp] = pack8(x);
            }
        }
    }
#pragma unroll 1
    for (int half = 0; half < 2; ++half) {
        int ln = lane; asm volatile("" : "+v"(ln));
        const int r2 = ln & 31, hh2 = ln >> 5;
        g2_load_vt(F, R1, h, half, R0 + 64 * c, ln);
#pragma unroll
        for (int st = 0; st < 2; ++st) {
            if (st <= ttd) {
#pragma unroll
                for (int sp = 0; sp < 2; ++sp)
#pragma unroll
                    for (int jl = 0; jl < 2; ++jl) {
                        const bf16x8 vf = g2_vfrag(R1, d, jl, st, sp, r2, hh2);
                        if (half == 0) o[jl] = MFMA32(vf, pa[st][sp], o[jl]); else o[2 + jl] = MFMA32(vf, pa[st][sp], o[2 + jl]);
                    }
            }
        }
    }
    if (d == 1) {
#pragma unroll
        for (int jt = 0; jt < 4; ++jt)
#pragma unroll
            for (int i = 0; i < 16; ++i) EX[(jt * 16 + i) * 64 + lane] = o[jt][i];
    }
    asm volatile("s_waitcnt lgkmcnt(0)" ::: "memory"); __syncthreads();
    if (d == 0) {
        float ss = 0.f;
#pragma unroll
        for (int jt = 0; jt < 4; ++jt)
#pragma unroll
            for (int i = 0; i < 16; ++i) { o[jt][i] += EX[(jt * 16 + i) * 64 + lane]; ss += o[jt][i] * o[jt][i]; }
        ss += __shfl_xor(ss, 32);
        const float rstd = 1.0f / sqrtf(ss * (1.0f / 128.0f) + 1e-6f);
#pragma unroll
        for (int jt = 0; jt < 4; ++jt)
#pragma unroll
            for (int q = 0; q < 4; ++q) {
                const int j = 32 * jt + 8 * q + 4 * hh; const float4 gn = *(const float4*)(F.gla_gain + j);
                u32x2 w; w.x = pk2(o[jt][4 * q + 0] * rstd * gn.x, o[jt][4 * q + 1] * rstd * gn.y); w.y = pk2(o[jt][4 * q + 2] * rstd * gn.z, o[jt][4 * q + 3] * rstd * gn.w);
                *(LAS u32x2*)(R1 + r * GO_ROW + j * 2) = w;
            }
        const int row0 = R0 + 64 * c + 32 * ttn;
#pragma unroll
        for (int i = 0; i < 8; ++i) {
            const int rl = 4 * i + (lane >> 4), ch = lane & 15;
            const u32x4 v = *(const LAS u32x4*)(R1 + rl * GO_ROW + ch * 16);
            const u32x4 gw = *(const u32x4*)(F.SG + (size_t)(row0 + rl) * 1024 + h * 128 + ch * 8);
            u32x4 w;
#pragma unroll
            for (int e = 0; e < 4; ++e) w[e] = pk2(bf2f((unsigned short)(v[e] & 0xffffu)) * bf2f((unsigned short)(gw[e] & 0xffffu)), bf2f((unsigned short)(v[e] >> 16)) * bf2f((unsigned short)(gw[e] >> 16)));
            *(u32x4*)(F.MGB + (size_t)(row0 + rl) * 1024 + h * 128 + ch * 8) = w;
        }
    }
    __syncthreads();
}

#ifndef PROBE_MIXSEL
#define PROBE_MIXSEL 0
#endif
__device__ __forceinline__ void gla1_slot(const Frame& F, LAS unsigned char* lds, int sl) {
    int tid = F.tid; asm volatile("" : "+v"(tid));
    const int wave = __builtin_amdgcn_readfirstlane(tid >> 6);
    gla1_unit(F, lds + wave * GW_BYTES, sl * 8 + wave, tid & 63);
    asm volatile("s_waitcnt vmcnt(0) lgkmcnt(0)" ::: "memory"); __syncthreads();
    if (sl >= 32) { gla2_scan(F, 16 + 2 * (sl - 32), F.tid); gla2_scan(F, 16 + 2 * (sl - 32) + 1, F.tid); }
    else {
        volatile LAS unsigned* flagw = (volatile LAS unsigned*)(lds + LDS_BYTES - 64 + 16);
        if (F.tid == 0) {
            __builtin_amdgcn_fence(__ATOMIC_RELEASE, "agent");
            asm volatile("s_waitcnt vmcnt(0)" ::: "memory");
            const unsigned old = __hip_atomic_fetch_add((unsigned*)(F.ws + WS_SEQCNT) + 64 * (sl >> 1), 1u, __ATOMIC_RELAXED, __HIP_MEMORY_SCOPE_AGENT);
            if (old == 1u) { __builtin_amdgcn_fence(__ATOMIC_ACQUIRE, "agent"); asm volatile("s_waitcnt vmcnt(0)" ::: "memory"); }
            flagw[0] = old;
        }
        __syncthreads();
        const unsigned old = flagw[0];
        __syncthreads();
        if (old == 1u) gla2_scan(F, sl >> 1, F.tid);
    }
    asm volatile("s_waitcnt vmcnt(0)" ::: "memory"); __syncthreads();
}
struct OneUnit { int pm, pn; bool has;
    __device__ __forceinline__ bool next(int i, pg8::Unit& u) const { if (i != 0 || !has) return false; u.pm = pm; u.pn = pn; return true; }
    __device__ __forceinline__ void a_ready(const pg8::Unit&) const {}
    __device__ __forceinline__ void done(const pg8::Unit&) const {} };
__device__ __forceinline__ OneUnit r1_unit(int L) {
    OneUnit o; const int x = L & 7, i = L >> 3; o.has = L < 256;
    if (i < 14) { o.pm = x + 16; o.pn = i; }
    else if (i < 30) { const int j = i - 14, k = j & 7; o.pm = x + 8 * (j >> 3); o.pn = k < 4 ? k : k + 2; }
    else { o.pm = x; o.pn = 4 + (i - 30); }
    return o;
}
__device__ __forceinline__ OneUnit r2_unit(int L) { OneUnit o; o.has = L < 80; if (L < 16) { o.pm = 8 + (L >> 1); o.pn = 4 + (L & 1); } else { const int q = L - 16; o.pm = q & 15; o.pn = 10 + (q >> 4); } return o; }

#define MIX_DEQUEUE(item, k, qsel) do { if ((k) == 0) item = F.bid; else { \
        if (F.tid == 0) qw[0] = F.G + __hip_atomic_fetch_add((unsigned*)(F.ws + WS_QHEAD) + 64 * (qsel), 1u, __ATOMIC_RELAXED, __HIP_MEMORY_SCOPE_AGENT); \
        __syncthreads(); item = (int)qw[0]; __syncthreads(); } } while (0)
__device__ __forceinline__ void attn_half(const Frame& F, LAS unsigned char* lds, int it, float lam) {
    const int pairid = it >> 1; attn_item<0>(F, lds, 1, pairid >> 5, (pairid >> 3) & 3, pairid & 7, lam, it & 1, pairid);
}
__device__ __forceinline__ void ph_mix_x(const Frame& F, LAS unsigned char* lds, int sel, int qsel) {
    const float lam = __builtin_bit_cast(float, __builtin_amdgcn_readfirstlane(__builtin_bit_cast(int, F.ROPE[2048])));
    constexpr int NITEM = 96 + 80 + 80;
    volatile LAS unsigned* qw = (volatile LAS unsigned*)(lds + LDS_BYTES - 64 + 32);
    for (int k = 0; ; ++k) {
        int item; MIX_DEQUEUE(item, k, qsel);
        if (item >= NITEM) break;
        const int kind = item < 96 ? 1 : (item < 176 ? 2 : 3);
        if (!(sel == 0 || sel == kind)) continue;
        if (kind == 1) gla1_slot(F, lds, item);
        else if (kind == 2) attn_half(F, lds, item - 96, lam);
        else {
            pg8::Gemm g{F.HB, F.WINT, NT, NIN, D}; const OneUnit S = r2_unit(item - 176);
            EpiInFast E{F.QG, F.KG, F.VGT, F.DQ, F.DKP, F.DVP, F.DKS, F.DVS, F.SG, F.LR, F.out, F.ROPE, nullptr};
            pg8::gemm_phase<EpiInFast, OneUnit, true, true>(lds, g, S, E);
            __syncthreads();
        }
    }
}
__device__ __forceinline__ void ph_mix_y(const Frame& F, LAS unsigned char* lds, int sel, int qsel) {
    const float lam = __builtin_bit_cast(float, __builtin_amdgcn_readfirstlane(__builtin_bit_cast(int, F.ROPE[2048])));
    constexpr int NITEM = 48 + 192 + 128;
    volatile LAS unsigned* qw = (volatile LAS unsigned*)(lds + LDS_BYTES - 64 + 32);
    for (int k = 0; ; ++k) {
        int item; MIX_DEQUEUE(item, k, qsel);
        if (item >= NITEM) break;
        const int kind = item < 48 ? 2 : (item < 240 ? 1 : 3);
        if (!(sel == 0 || sel == kind)) continue;
        if (kind == 2) attn_half(F, lds, 80 + item, lam);
        else if (kind == 1) gla3_slot(F, lds, item - 48, F.tid);
        else { const int it = item - 240; attn_item<0>(F, lds, 0, it >> 3, (it >> 1) & 3, it & 1, lam, -1, 0); }
    }
}

__device__ void ph_merge(const Frame& F) {
    for (int r = F.bid * 8 + F.wave; r < NT; r += F.G * 8) {
#pragma unroll
        for (int g = 0; g < 1; ++g)
#pragma unroll
            for (int h = 0; h < 4; ++h) {
                const int c = h * 128 + F.lane * 2;
                float2 v;
                if (g == 0) { const float2 a = *(const float2*)(F.OGF + (size_t)r * 512 + c), bb = *(const float2*)(F.OGB + (size_t)r * 512 + c); v.x = a.x + bb.x; v.y = a.y + bb.y; }
                else v = *(const float2*)(F.OD + (size_t)r * 512 + c);
                const float ss = wave_sum(v.x * v.x + v.y * v.y);
                const float rstd = 1.0f / sqrtf(ss * (1.0f / 128.0f) + 1e-6f);
                const float* gain = (g == 0 ? F.gla_gain : F.diff_gain) + F.lane * 2;
                const float sc = g == 0 ? 1.0f : 0.8f;
                const float2 gt = *(const float2*)(F.P + (size_t)r * PW + C_GATE + g * 512 + c);
                float2 o; o.x = v.x * rstd * gain[0] * sc * silu_f(gt.x); o.y = v.y * rstd * gain[1] * sc * silu_f(gt.y);
                *(unsigned*)(F.MGB + (size_t)r * D + g * 512 + c) = pk2(o.x, o.y);
            }
    }
}
__device__ __forceinline__ void ph_final(const Frame& F) {
    for (int r = F.bid * 8 + F.wave; r < NT; r += F.G * 8) {
        float* y = F.out + (size_t)r * D;
        float4 v[4]; float ss = 0.f;
#pragma unroll
        for (int i = 0; i < 4; ++i) { v[i] = *(const float4*)(y + i * 256 + F.lane * 4); ss += v[i].x * v[i].x + v[i].y * v[i].y + v[i].z * v[i].z + v[i].w * v[i].w; }
        ss = wave_sum(ss);
        const float rstd = 1.0f / sqrtf(ss * (1.0f / 1024.0f) + 1e-6f);
#pragma unroll
        for (int i = 0; i < 4; ++i) {
            const int k = i * 256 + F.lane * 4; const float4 g = *(const float4*)(F.final_gain + k);
            float4 o; o.x = v[i].x * rstd * g.x; o.y = v[i].y * rstd * g.y; o.z = v[i].z * rstd * g.z; o.w = v[i].w * rstd * g.w;
            *(float4*)(y + k) = o;
        }
    }
}


__device__ __forceinline__ void frame_derive(Frame& F, unsigned char* ws0) {
    size_t zoff = 0; asm volatile("" : "+s"(zoff));
    unsigned char* ws = ws0 + zoff;
    F.ws = ws;
    F.MOD = (float*)(ws + WS_MOD); F.H = nullptr; F.P = (float*)(ws + WS_P);
    F.OGF = (float*)(ws + WS_OGF); F.OGB = (float*)(ws + WS_OGB); F.OD = (float*)(ws + WS_OD); F.MG = (float*)(ws + WS_MG);
    F.ROPE = (float*)(ws + WS_ROPE); F.LR = (float*)(ws + WS_LR);
    F.WINT = (bf16_t*)(ws + WS_WINT); F.WOT = (bf16_t*)(ws + WS_WOT); F.HB = (bf16_t*)(ws + WS_HB); F.QG = (bf16_t*)(ws + WS_QG); F.KG = (bf16_t*)(ws + WS_KG); F.VG = (bf16_t*)(ws + WS_VG);
    F.DQ = (bf16_t*)(ws + WS_DQ); F.DKP = (bf16_t*)(ws + WS_DKP); F.DVP = (bf16_t*)(ws + WS_DVP); F.DKS = (bf16_t*)(ws + WS_DKS); F.DVS = (bf16_t*)(ws + WS_DVS);
    F.SG = (bf16_t*)(ws + WS_SG); F.MGB = (bf16_t*)(ws + WS_MGB); F.VGT = (bf16_t*)(ws + WS_VGT); F.GSC = ws + WS_GSC;
}

#ifndef DEBUG_P
#define DEBUG_P 0
#endif
#ifndef PROBE_REPEAT
#define PROBE_REPEAT -1
#endif
#ifndef PROBE_AVAR
#define PROBE_AVAR 0
#endif
#ifndef PROBE_NREP
#define PROBE_NREP 2
#endif
constexpr int NPH = 6;
__global__ void __launch_bounds__(NTHR, 2) mega(Args args) {
    extern __shared__ __attribute__((aligned(16))) unsigned char lds_raw[];
    LAS unsigned char* lds = (LAS unsigned char*)lds_raw;
    Frame F;
    F.x_prompt = args.in[0]; F.x_sample = args.in[1]; F.cache_k = args.in[2]; F.cache_v = args.in[3]; F.st_f = args.in[4]; F.st_b = args.in[5];
    F.c = args.in[6]; F.c_ctx = args.in[7]; F.norm_gain = args.in[8]; F.w_mod = args.in[9]; F.b_mod = args.in[10]; F.w_in = args.in[11];
    F.w_alpha = args.in[12]; F.b_alpha = args.in[13]; F.dlam = args.in[14]; F.gla_gain = args.in[15]; F.diff_gain = args.in[16]; F.w_out = args.in[17]; F.final_gain = args.in[18];
    F.out = args.out; F.ws = args.ws;
    unsigned char* ws = args.ws;
    F.tid = threadIdx.x; F.lane = F.tid & 63; F.wave = F.tid >> 6; F.G = gridDim.x; F.bid = blockIdx.x;
    volatile LAS unsigned* misc = (volatile LAS unsigned*)(lds + LDS_BYTES - 64);
    if (F.tid < 16) misc[F.tid] = 0u;
    __syncthreads();
    const int lo = args.ph_lo, hi = args.ph_hi;
    XcdBarrier bar; bar.bar = (unsigned*)(ws + WS_CTL) + 1024; bar.x = 0; bar.st = nullptr;
    if (hi - lo > 1) bar = xcd_barrier_post((unsigned*)(ws + WS_CTL) + 1024, misc);
#define IN(k) (lo <= (k) && (k) < hi)
#define SEAM(k) do { if (IN(k) && IN((k) + 1)) xcd_barrier(bar); } while (0)
    LAS float* ldsf = (LAS float*)lds;

#define REPS(k) _Pragma("unroll 1") for (int rep = 0, nrep_ = (args.rp == (k) ? args.nr : 1); rep < nrep_; ++rep)
#define REPBAR() do { if (rep) xcd_barrier(bar); } while (0)
    if (IN(0)) { REPS(0) { REPBAR(); frame_derive(F, ws); ph_prep(F, lds, rep == 0); } } SEAM(0);
    if (IN(1)) { REPS(1) { REPBAR(); frame_derive(F, ws); ph_hb(F, lds); } } SEAM(1);
    if (IN(2)) {
        REPS(2) { REPBAR();
        frame_derive(F, ws);
        pg8::Gemm g{F.HB, F.WINT, NT, NIN, D}; const OneUnit S = r1_unit(F.bid);
        EpiInFast E{F.QG, F.KG, F.VGT, F.DQ, F.DKP, F.DVP, F.DKS, F.DVS, F.SG, F.LR, F.out, F.ROPE, DEBUG_P ? F.P : nullptr};
        pg8::gemm_phase<EpiInFast, OneUnit, true, true>(lds, g, S, E);
        }
    } SEAM(2);
    if (IN(3)) {
        REPS(30) { REPBAR(); frame_derive(F, ws); ph_mix_x(F, lds, rep ? args.msel : 0, rep); }
        xcd_barrier(bar);
        REPS(3) { REPBAR(); frame_derive(F, ws); ph_mix_y(F, lds, rep ? args.msel : 0, 2 + rep); }
    } SEAM(3);
    if (IN(4)) {
        REPS(4) { REPBAR();
        frame_derive(F, ws);
        pg8::Gemm g{F.MGB, F.WOT, NT, D, D}; pg8::StaticOrder S; S.init(NT, D, F.G, F.bid);
        EpiOutFast E{F.x_prompt, F.x_sample, F.MOD, F.out};
        pg8::gemm_phase<EpiOutFast, pg8::StaticOrder, true, true>(lds, g, S, E);
        }
    } SEAM(4);
    if (IN(5)) {
        frame_derive(F, ws); ph_final(F);
    }
#undef IN
#undef SEAM
}

extern "C" void kernel_launch(void* const* d_in, const int* in_sizes, int n_in, void* d_out, int out_size, void* d_ws, size_t ws_size, hipStream_t stream) {
    static int grid = 0;
    if (grid == 0) {
        if (n_in != 19 || out_size != 11534336 || ws_size < WS_END) { fprintf(stderr, "kernel_launch: unexpected shapes n_in %d out %d ws %zu\n", n_in, out_size, ws_size); grid = -1; return; }
        int dev = 0, cus = 0;
        if (hipGetDevice(&dev) != hipSuccess || hipDeviceGetAttribute(&cus, hipDeviceAttributeMultiprocessorCount, dev) != hipSuccess) { grid = -1; return; }
        if (hipFuncSetAttribute((const void*)mega, hipFuncAttributeMaxDynamicSharedMemorySize, LDS_BYTES) != hipSuccess) { fprintf(stderr, "kernel_launch: hipFuncSetAttribute failed\n"); grid = -1; return; }
        grid = cus;
    }
    if (grid < 0) return;
    (void)hipMemsetAsync((char*)d_ws + WS_CTL, 0, CTL_ZERO_BYTES, stream);
    Args a{};
    for (int i = 0; i < 19; ++i) a.in[i] = (const float*)d_in[i];
    a.out = (float*)d_out; a.ws = (unsigned char*)d_ws;
    a.rp = PROBE_REPEAT; a.nr = PROBE_NREP; a.msel = PROBE_MIXSEL; a.pad = 0;
    if (MK_N_LAUNCHES == 1) {
        a.ph_lo = 0; a.ph_hi = NPH;
        hipLaunchKernelGGL(mega, dim3(grid), dim3(NTHR), LDS_BYTES, stream, a);
    } else {
        for (int p = 0; p < NPH; ++p) { a.ph_lo = p; a.ph_hi = p + 1; hipLaunchKernelGGL(mega, dim3(grid), dim3(NTHR), LDS_BYTES, stream, a); }
    }
}
```
